# Optimizing an MI355X kernel written in HIP

```python
import math
import jax, jax.numpy as jnp
from jax import lax
import numpy as np

D_MODEL = 2048
BATCH = 8
SEQ = 2048
DEPTH = 1

D_RNN = D_MODEL
LRU_BLOCKS = 16
LRU_BLOCK = D_RNN // LRU_BLOCKS
LRU_CONV = 4
LRU_C = 8.0
N_HEADS = 16
HEAD_DIM = 128
IDX_HEADS = 16
IDX_DIM = 64
TOPK_MAX = 256
Q_BLOCK = 128
REL_BUCKETS = 32
REL_MAX_DIST = 128
D_FF = 3 * D_MODEL
FFN_CONV = 3
LN_EPS = 1e-5
ALPHA = (2.0 * DEPTH) ** 0.25
BETA = (8.0 * DEPTH) ** -0.25

SPLITS = (D_RNN, D_RNN, N_HEADS * HEAD_DIM, HEAD_DIM, HEAD_DIM,
          IDX_HEADS * IDX_DIM, IDX_DIM, IDX_HEADS, D_MODEL, D_MODEL)
D_IN = sum(SPLITS)
OFFSETS = tuple(int(v) for v in np.cumsum(SPLITS)[:-1])

kernel_name = "hybrid_rglru_dsa_convffn_deepnorm"


def layer_norm(x, g, b):
    xf = x.astype(jnp.float32)
    mu = jnp.mean(xf, axis=-1, keepdims=True)
    var = jnp.mean(jnp.square(xf - mu), axis=-1, keepdims=True)
    y = (xf - mu) * lax.rsqrt(var + LN_EPS) * g.astype(jnp.float32) + b.astype(jnp.float32)
    return y.astype(x.dtype)


def causal_dwconv(x, w, b):
    width = w.shape[0]
    S = x.shape[1]
    xp = jnp.pad(x, ((0, 0), (width - 1, 0), (0, 0)))
    y = b + xp[:, 0:S] * w[0]
    for j in range(1, width):
        y = y + xp[:, j:j + S] * w[j]
    return y


def t5_bucket(rel):
    max_exact = REL_BUCKETS // 2
    nf = jnp.maximum(rel, 1).astype(jnp.float32)
    large = max_exact + (jnp.log(nf / max_exact) / math.log(REL_MAX_DIST / max_exact)
                         * (REL_BUCKETS - max_exact)).astype(jnp.int32)
    large = jnp.minimum(large, REL_BUCKETS - 1)
    return jnp.where(rel < max_exact, rel, large)


def rg_lru(x, gate_a_w, gate_a_b, gate_x_w, gate_x_b, lam):
    B, S, _ = x.shape
    xb = x.reshape(B, S, LRU_BLOCKS, LRU_BLOCK)
    r = jax.nn.sigmoid(jnp.einsum('bsnj,njk->bsnk', xb, gate_a_w).reshape(B, S, D_RNN) + gate_a_b)
    i = jax.nn.sigmoid(jnp.einsum('bsnj,njk->bsnk', xb, gate_x_w).reshape(B, S, D_RNN) + gate_x_b)
    log_a = -LRU_C * r.astype(jnp.float32) * jax.nn.softplus(-lam.astype(jnp.float32))
    a = jnp.exp(log_a)
    mult = jnp.sqrt(-jnp.expm1(2.0 * log_a))
    first = (jnp.arange(S) == 0)[None, :, None]
    mult = jnp.where(first, 1.0, mult)
    u = mult * (i * x).astype(jnp.float32)

    def combine(left, right):
        a1, b1 = left
        a2, b2 = right
        return a1 * a2, a2 * b1 + b2

    _, h = lax.associative_scan(combine, (a, u), axis=1)
    return h.astype(x.dtype)


def sparse_attention(q, k, v, qi, ki, wi, rel_bias, top_k):
    B, S, H, Dh = q.shape
    nb = S // Q_BLOCK
    qi32 = qi.astype(jnp.float32)
    ki32 = ki.astype(jnp.float32)
    wi32 = wi.astype(jnp.float32) * (IDX_HEADS ** -0.5)
    key_pos = jnp.arange(S)

    def to_blocks(t):
        return jnp.moveaxis(t.reshape((B, nb, Q_BLOCK) + t.shape[2:]), 1, 0)

    q_blocks = to_blocks(q)
    qi_blocks = to_blocks(qi32)
    wi_blocks = to_blocks(wi32)
    t_blocks = jnp.arange(S, dtype=jnp.int32).reshape(nb, Q_BLOCK)
    gather = jax.vmap(lambda tb, ib: tb[ib])

    def block_fn(args):
        q_b, qi_b, w_b, t_b = args
        dots = jnp.einsum('bthd,bsd->bths', qi_b, ki32) * (IDX_DIM ** -0.5)
        score = jnp.einsum('bths,bth->bts', jax.nn.relu(dots), w_b)
        causal = key_pos[None, :] <= t_b[:, None]
        score = jnp.where(causal[None], score, -jnp.inf)
        _, idx = lax.top_k(score, top_k)
        valid = idx <= t_b[None, :, None]
        k_sel = gather(k, idx)
        v_sel = gather(v, idx)
        logits = jnp.einsum('bthd,btkd->bhtk', q_b, k_sel).astype(jnp.float32) * (Dh ** -0.5)
        rel = t_b[None, :, None] - idx
        bias = rel_bias[t5_bucket(rel)].astype(jnp.float32)
        logits = logits + jnp.transpose(bias, (0, 3, 1, 2))
        logits = jnp.where(valid[:, None], logits, -jnp.inf)
        p = jax.nn.softmax(logits, axis=-1).astype(v.dtype)
        return jnp.einsum('bhtk,btkd->bthd', p, v_sel)

    out = lax.map(block_fn, (q_blocks, qi_blocks, wi_blocks, t_blocks))
    return jnp.moveaxis(out, 0, 1).reshape(B, S, H * Dh)


def setup_inputs(seed: int = 0) -> dict:
    key = jax.random.key(seed)
    ks = jax.random.split(key, 24)

    def nrm(k, shape, scale):
        return jax.random.normal(k, shape, jnp.float32) * scale

    u = jax.random.uniform(ks[9], (DEPTH, D_RNN), jnp.float32, minval=0.9 ** 2, maxval=0.999 ** 2)
    lru_lambda = -jnp.log(jnp.expm1(-0.5 * jnp.log(u)))
    return {
        "x": nrm(ks[0], (BATCH, SEQ, D_MODEL), 1.0),
        "w_in": nrm(ks[1], (DEPTH, D_MODEL, D_IN), D_MODEL ** -0.5),
        "lru_conv_w": nrm(ks[2], (DEPTH, LRU_CONV, D_RNN), LRU_CONV ** -0.5),
        "lru_conv_b": nrm(ks[3], (DEPTH, D_RNN), 0.01),
        "lru_gate_a_w": nrm(ks[4], (DEPTH, LRU_BLOCKS, LRU_BLOCK, LRU_BLOCK), LRU_BLOCK ** -0.5),
        "lru_gate_a_b": nrm(ks[5], (DEPTH, D_RNN), 0.01),
        "lru_gate_x_w": nrm(ks[6], (DEPTH, LRU_BLOCKS, LRU_BLOCK, LRU_BLOCK), LRU_BLOCK ** -0.5),
        "lru_gate_x_b": nrm(ks[7], (DEPTH, D_RNN), 0.01),
        "lru_lambda": lru_lambda,
        "idx_knorm_g": 1.0 + nrm(ks[10], (DEPTH, IDX_DIM), 0.01),
        "idx_knorm_b": nrm(ks[11], (DEPTH, IDX_DIM), 0.01),
        "rel_bias": nrm(ks[12], (REL_BUCKETS, N_HEADS), 0.1),
        "w_proj_lru": nrm(ks[13], (DEPTH, D_RNN, D_MODEL), D_RNN ** -0.5),
        "w_proj_attn": nrm(ks[14], (DEPTH, N_HEADS * HEAD_DIM, D_MODEL), (N_HEADS * HEAD_DIM) ** -0.5),
        "w_out": nrm(ks[15], (DEPTH, D_MODEL, D_MODEL), D_MODEL ** -0.5 * BETA),
        "ln1_g": 1.0 + nrm(ks[16], (DEPTH, D_MODEL), 0.01),
        "ln1_b": nrm(ks[17], (DEPTH, D_MODEL), 0.01),
        "ffn_w_up": nrm(ks[18], (DEPTH, D_MODEL, 2 * D_FF), D_MODEL ** -0.5),
        "ffn_conv_w": nrm(ks[19], (DEPTH, FFN_CONV, 2 * D_FF), FFN_CONV ** -0.5),
        "ffn_conv_b": nrm(ks[20], (DEPTH, 2 * D_FF), 0.01),
        "ffn_w_down": nrm(ks[21], (DEPTH, D_FF, D_MODEL), D_FF ** -0.5 * BETA),
        "ln2_g": 1.0 + nrm(ks[22], (DEPTH, D_MODEL), 0.01),
        "ln2_b": nrm(ks[23], (DEPTH, D_MODEL), 0.01),
    }


def reference(x, w_in, lru_conv_w, lru_conv_b, lru_gate_a_w, lru_gate_a_b, lru_gate_x_w, lru_gate_x_b,
              lru_lambda, idx_knorm_g, idx_knorm_b, rel_bias, w_proj_lru, w_proj_attn, w_out,
              ln1_g, ln1_b, ffn_w_up, ffn_conv_w, ffn_conv_b, ffn_w_down, ln2_g, ln2_b):
    B, S, _ = x.shape
    top_k = min(TOPK_MAX, S // 4)
    h = x
    for l in range(DEPTH):
        proj = h @ w_in[l]
        lru_x, lru_g, q, k, v, qi, ki, wi, g_lru, g_att = jnp.split(proj, OFFSETS, axis=-1)
        lru_x = causal_dwconv(lru_x, lru_conv_w[l], lru_conv_b[l])
        y_lru = jax.nn.gelu(lru_g, approximate=True) * rg_lru(
            lru_x, lru_gate_a_w[l], lru_gate_a_b[l], lru_gate_x_w[l], lru_gate_x_b[l], lru_lambda[l])
        q = q.reshape(B, S, N_HEADS, HEAD_DIM)
        qi = qi.reshape(B, S, IDX_HEADS, IDX_DIM)
        ki = layer_norm(ki, idx_knorm_g[l], idx_knorm_b[l])
        y_att = sparse_attention(q, k, v, qi, ki, wi, rel_bias, top_k)
        merged = (jax.nn.sigmoid(g_lru) * (y_lru @ w_proj_lru[l])
                  + jax.nn.sigmoid(g_att) * (y_att @ w_proj_attn[l]))
        h = layer_norm(ALPHA * h + merged @ w_out[l], ln1_g[l], ln1_b[l])
        up = causal_dwconv(h @ ffn_w_up[l], ffn_conv_w[l], ffn_conv_b[l])
        up_g, up_v = jnp.split(up, 2, axis=-1)
        ffn = (jax.nn.gelu(up_g, approximate=True) * up_v) @ ffn_w_down[l]
        h = layer_norm(ALPHA * h + ffn, ln2_g[l], ln2_b[l])
    return h
```

```cpp
#include <hip/hip_runtime.h>
#include <hip/hip_cooperative_groups.h>
#include <cstdio>
#include <cstdint>
namespace cg = cooperative_groups;
namespace pg8 {
#define PG8_LAS __attribute__((address_space(3)))
typedef unsigned short bf16_t;
typedef short bf16x8 __attribute__((ext_vector_type(8)));
typedef float f32x4 __attribute__((ext_vector_type(4)));
typedef unsigned u32x4 __attribute__((ext_vector_type(4)));
constexpr int BM = 256, BK = 64, HALF = 128, HTB = HALF * BK * 2  , STAGE_BYTES = 8 * HTB, NXCD = 8, WGM = 8;

__host__ __device__ __forceinline__ int lds_byte(int r, int c) { const int st = (r >> 4) * 2 + (c >> 5), rr = r & 15, cc = c & 31, ob = rr * 64 + cc * 2; return st * 1024 + (ob ^ (((ob >> 9) & 1) << 5)); }
__host__ __device__ __forceinline__ void stage_rc(int b, int& R, int& C) { const int st = b / 1024, sb = b % 1024, swz = sb ^ (((sb >> 9) & 1) << 5); R = (st >> 1) * 16 + swz / 64; C = (st & 1) * 32 + (swz % 64) / 2; }
__host__ __device__ __forceinline__ int perm32(int rho) { const int n = rho >> 4, i = rho & 15; return 8 * (i >> 2) + 4 * n + (i & 3); }

struct Unit { int pm, pn; };
struct Gemm { const bf16_t* A; const bf16_t* Bt; int M, N, K, lda; size_t aalt; };

struct StaticOrder {
    int nM, nN, nwg, G, c;
    __host__ __device__ void init(int M, int N, int G_, int c_) { nM = M / BM; nN = N / BM; nwg = nM * nN; G = G_; c = c_; }
    __host__ __device__ bool next(int i, Unit& u) const {
        const long L = (long)i * G + c; if (L >= nwg) return false;
        int wgid = (int)L; { const int q = nwg / NXCD, r = nwg % NXCD, xcd = wgid % NXCD, off = wgid / NXCD; wgid = (xcd < r ? xcd * (q + 1) : r * (q + 1) + (xcd - r) * q) + off; }
        const int nig = WGM * nN, gid = wgid / nig, fm = gid * WGM, gsz = (nM - fm) < WGM ? (nM - fm) : WGM;
        u.pm = fm + ((wgid % nig) % gsz); u.pn = (wgid % nig) / gsz; return true;
    }
    __device__ __forceinline__ void a_ready(const Unit&) const {}
    __device__ __forceinline__ void done(const Unit&) const {}
};

__device__ __forceinline__ unsigned cvt_pk_bf16(float lo, float hi) { unsigned r; asm volatile("v_cvt_pk_bf16_f32 %0, %1, %2" : "=v"(r) : "v"(lo), "v"(hi)); return r; }
typedef float f32x2 __attribute__((ext_vector_type(2)));
__device__ __forceinline__ f32x2 gelu_pk(f32x2 v) {
    const f32x2 av = __builtin_elementwise_abs(v), d = av * 0.2316418882f + 1.0f;
    f32x2 t; t.x = __builtin_amdgcn_rcpf(d.x); t.y = __builtin_amdgcn_rcpf(d.y);
    f32x2 q = t * 0.5307027145f + (-0.7265760135f); q = q * t + 0.7107068705f; q = q * t + (-0.142248368f); q = q * t + 0.127414796f; q = q * t;
    const f32x2 s = (v * v) * (-0.72134752044f);
    f32x2 e; e.x = __builtin_amdgcn_exp2f(s.x); e.y = __builtin_amdgcn_exp2f(s.y);
    const f32x2 m = v * (q * e), r = v - m;
    f32x2 o; o.x = v.x < 0.f ? m.x : r.x; o.y = v.y < 0.f ? m.y : r.y; return o;
}

template <int ACT  > struct EpiBf16 {
    static constexpr bool PERM = true, AFTER_DRAIN = false, MID = false; static_assert(ACT == 0 || ACT == 1, "EpiBf16: ACT is 0 (none) or 1 (gelu_pk)");
    bf16_t* O; int ldc; const float* bias; int split_cols; size_t split_stride; float scale0;
    __device__ __forceinline__ void operator()(const f32x4 (&acc)[2][2][4][2], const Unit& u, int wr, int wc, int fr, int fq) const {
        const int row0 = u.pm * BM + wr * 64 + fr; int colt = u.pn * BM; bf16_t* base = O;
        float sc = 1.f; if (split_cols) { const int t = colt / split_cols; base += (size_t)t * split_stride; colt -= t * split_cols; if (t == 0) sc = scale0; }
        const int col0 = colt + wc * 32 + 8 * fq, bcol0 = u.pn * BM + wc * 32 + 8 * fq;
        f32x4 bv[2][2];
#pragma unroll
        for (int bj = 0; bj < 2; ++bj)
#pragma unroll
            for (int n = 0; n < 2; ++n) bv[bj][n] = bias ? *(const f32x4*)(bias + bcol0 + bj * HALF + 4 * n) : (f32x4){0.f, 0.f, 0.f, 0.f};
#pragma unroll
        for (int ai = 0; ai < 2; ++ai)
#pragma unroll
            for (int m = 0; m < 4; ++m) { bf16_t* rowp = base + (size_t)(row0 + ai * HALF + m * 16) * ldc + col0;
#pragma unroll
                for (int bj = 0; bj < 2; ++bj) { f32x4 v0 = acc[ai][bj][m][0] + bv[bj][0], v1 = acc[ai][bj][m][1] + bv[bj][1];
                    if (ACT == 1) { f32x2 a = gelu_pk((f32x2){v0[0], v0[1]}), b = gelu_pk((f32x2){v0[2], v0[3]}), c = gelu_pk((f32x2){v1[0], v1[1]}), d = gelu_pk((f32x2){v1[2], v1[3]});
                        v0 = (f32x4){a.x, a.y, b.x, b.y}; v1 = (f32x4){c.x, c.y, d.x, d.y}; }
                    v0 = v0 * sc; v1 = v1 * sc; u32x4 w; w.x = cvt_pk_bf16(v0[0], v0[1]); w.y = cvt_pk_bf16(v0[2], v0[3]); w.z = cvt_pk_bf16(v1[0], v1[1]); w.w = cvt_pk_bf16(v1[2], v1[3]);
                    *(u32x4*)(rowp + bj * HALF) = w; } }
    }
};

__device__ __forceinline__ float blo(unsigned u) { return __uint_as_float(u << 16); }
__device__ __forceinline__ float bhi(unsigned u) { return __uint_as_float(u & 0xffff0000u); }
struct PairOrder {
    int nM, nN, nwg, G, c;
    __host__ __device__ void init(int M, int N, int G_, int c_) { nM = M / BM; nN = N / BM; nwg = nM * nN; G = G_; c = c_; }
    __host__ __device__ bool next(int i, Unit& u) const {
        const long L = (long)(i >> 1) * G + c; if (L >= nwg) return false;
        int wgid = (int)L; { const int q = nwg / NXCD, r = nwg % NXCD, xcd = wgid % NXCD, off = wgid / NXCD; wgid = (xcd < r ? xcd * (q + 1) : r * (q + 1) + (xcd - r) * q) + off; }
        const int nig = WGM * nN, gid = wgid / nig, fm = gid * WGM, gsz = (nM - fm) < WGM ? (nM - fm) : WGM;
        u.pm = fm + ((wgid % nig) % gsz); u.pn = 2 * ((wgid % nig) / gsz) + (i & 1); return true;
    }
    __device__ __forceinline__ void a_ready(const Unit&) const {}
    __device__ __forceinline__ void done(const Unit&) const {}
};
struct EpiMerge {
    static constexpr bool PERM = true, AFTER_DRAIN = false, MID = false;
    const bf16_t* G; int ldg, cgl, cga; float* tmp; int ldt; bf16_t* O; int ldc;
    __device__ __forceinline__ void operator()(f32x4 (&acc)[2][2][4][2], const Unit& u, int wr, int wc, int fr, int fq) const {
        const int sel = u.pn & 1; const int row0 = u.pm * BM + wr * 64 + fr, col0 = (u.pn >> 1) * BM + wc * 32 + 8 * fq; const int cg = sel ? cga : cgl;
        u32x4 L[2][2];
        { const bf16_t* rowp = G + (size_t)row0 * ldg + col0 + cg; L[0][0] = *(const u32x4*)(rowp); L[0][1] = *(const u32x4*)(rowp + HALF); }
#pragma unroll
        for (int idx = 0; idx < 8; ++idx) { const int ai = idx >> 2, m = idx & 3; const size_t r = (size_t)(row0 + ai * HALF + m * 16);
            if (idx < 7) { const int ai2 = (idx + 1) >> 2, m2 = (idx + 1) & 3; const bf16_t* rowp = G + (size_t)(row0 + ai2 * HALF + m2 * 16) * ldg + col0 + cg;
                L[(idx + 1) & 1][0] = *(const u32x4*)(rowp); L[(idx + 1) & 1][1] = *(const u32x4*)(rowp + HALF); }
#pragma unroll
            for (int bj = 0; bj < 2; ++bj) { u32x4 ga = L[idx & 1][bj];
                asm volatile("" : "+v"(ga));
                f32x4 o0, o1;
#pragma unroll
                for (int k = 0; k < 4; ++k) { const unsigned a = ga[k];
                    const float s0 = __builtin_amdgcn_rcpf(1.0f + __expf(-blo(a))), s1 = __builtin_amdgcn_rcpf(1.0f + __expf(-bhi(a)));
                    if (k < 2) { o0[2 * k] = acc[ai][bj][m][0][2 * k] * s0; o0[2 * k + 1] = acc[ai][bj][m][0][2 * k + 1] * s1; }
                    else { o1[2 * k - 4] = acc[ai][bj][m][1][2 * k - 4] * s0; o1[2 * k - 3] = acc[ai][bj][m][1][2 * k - 3] * s1; } }
                float* tp = tmp + r * ldt + col0 + bj * HALF;
                if (sel == 0) { *(f32x4*)tp = o0; *(f32x4*)(tp + 4) = o1; }
                else { const f32x4 t0 = *(const f32x4*)tp, t1 = *(const f32x4*)(tp + 4); o0 += t0; o1 += t1;
                    u32x4 w; w.x = cvt_pk_bf16(o0[0], o0[1]); w.y = cvt_pk_bf16(o0[2], o0[3]); w.z = cvt_pk_bf16(o1[0], o1[1]); w.w = cvt_pk_bf16(o1[2], o1[3]);
                    *(u32x4*)(O + r * ldc + col0 + bj * HALF) = w; } } }
    }
};
struct EpiResid {
    static constexpr bool PERM = false, AFTER_DRAIN = false, MID = false;
    const float* base; float* out; int ldc; float alpha;
    __device__ __forceinline__ void operator()(f32x4 (&acc)[2][2][4][2], const Unit& u, int wr, int wc, int fr, int fq) const {
        const int row0 = u.pm * BM + wr * 64 + fr, col0 = u.pn * BM + wc * 32 + 4 * fq;
#pragma unroll
        for (int ai = 0; ai < 2; ++ai)
#pragma unroll
            for (int m = 0; m < 4; ++m) { const size_t off = (size_t)(row0 + ai * HALF + m * 16) * ldc + col0;
#pragma unroll
                for (int bj = 0; bj < 2; ++bj)
#pragma unroll
                    for (int n = 0; n < 2; ++n) { const f32x4 bs = *(const f32x4*)(base + off + bj * HALF + n * 16); *(f32x4*)(out + off + bj * HALF + n * 16) = bs * alpha + acc[ai][bj][m][n]; } }
    }
};
__device__ __forceinline__ float dpp_prev1(float cur, float prev) {
    const int o = __builtin_amdgcn_update_dpp(0, __builtin_bit_cast(int, prev), 0x10F, 0xf, 0xf, true);
    return __builtin_bit_cast(float, __builtin_amdgcn_update_dpp(o, __builtin_bit_cast(int, cur), 0x111, 0xf, 0xf, false));
}
__device__ __forceinline__ float dpp_prev2(float cur, float prev) {
    const int o = __builtin_amdgcn_update_dpp(0, __builtin_bit_cast(int, prev), 0x10E, 0xf, 0xf, true);
    return __builtin_bit_cast(float, __builtin_amdgcn_update_dpp(o, __builtin_bit_cast(int, cur), 0x112, 0xf, 0xf, false));
}
struct EpiGeglu {
    static constexpr bool PERM = true, AFTER_DRAIN = false, MID = false;
    bf16_t* act; int ldact; const float* cw; const float* cb; float* head; float* tail; int nch;
    __device__ __forceinline__ void operator()(f32x4 (&acc)[2][2][4][2], const Unit& u, int wr, int wc, int fr, int fq) const {
        const int chb = u.pn * HALF + wc * 32 + 8 * fq;
        if (fr < 2 || fr >= 14) { const bool hd = fr < 2; float* eb = hd ? head : tail; const int er = hd ? fr : fr - 14;
#pragma unroll
            for (int ai = 0; ai < 2; ++ai) { float* ep = eb + ((size_t)(u.pm * 4 + ai * 2 + wr) * 2 + er) * (2 * nch) + u.pn * BM + wc * 32 + 8 * fq;
#pragma unroll
                for (int bj = 0; bj < 2; ++bj)
#pragma unroll
                    for (int n = 0; n < 2; ++n) { const f32x4 v0 = acc[ai][bj][0][n], v3 = acc[ai][bj][3][n]; f32x4 v; v[0] = hd ? v0[0] : v3[0]; v[1] = hd ? v0[1] : v3[1]; v[2] = hd ? v0[2] : v3[2]; v[3] = hd ? v0[3] : v3[3];
                        *(f32x4*)(ep + bj * HALF + 4 * n) = v; } } }
        __builtin_amdgcn_sched_barrier(0);
        f32x4 W[2][4];
        { const int cc = chb; W[0][0] = *(const f32x4*)(cw + cc); W[0][1] = *(const f32x4*)(cw + 2 * nch + cc); W[0][2] = *(const f32x4*)(cw + 4 * nch + cc); W[0][3] = *(const f32x4*)(cb + cc); }
#pragma unroll
        for (int idx = 0; idx < 4; ++idx) { const int n = idx >> 1, bj = idx & 1;
            if (idx < 3) { const int cc = ((idx + 1) & 1) * nch + chb + 4 * ((idx + 1) >> 1);
                W[(idx + 1) & 1][0] = *(const f32x4*)(cw + cc); W[(idx + 1) & 1][1] = *(const f32x4*)(cw + 2 * nch + cc); W[(idx + 1) & 1][2] = *(const f32x4*)(cw + 4 * nch + cc); W[(idx + 1) & 1][3] = *(const f32x4*)(cb + cc); }
            f32x4 w0 = W[idx & 1][0], w1 = W[idx & 1][1], w2 = W[idx & 1][2], bb = W[idx & 1][3];
            asm volatile("" : "+v"(w0), "+v"(w1), "+v"(w2), "+v"(bb));
#pragma unroll
            for (int ai = 0; ai < 2; ++ai) {
#pragma unroll
                for (int m = 3; m >= 0; --m) {
                    const f32x4 cur = acc[ai][bj][m][n], prv = acc[ai][bj][m > 0 ? m - 1 : 0][n]; f32x4 o;
#pragma unroll
                    for (int k = 0; k < 4; ++k) { const float p1 = dpp_prev1(cur[k], prv[k]), p2 = dpp_prev2(cur[k], prv[k]); o[k] = bb[k] + w0[k] * p2 + w1[k] * p1 + w2[k] * cur[k]; }
                    asm volatile("" : "+v"(o));
                    acc[ai][bj][m][n] = o;
                }
            }
            if (bj == 1) {
#pragma unroll
                for (int ai = 0; ai < 2; ++ai)
#pragma unroll
                    for (int m = 0; m < 4; ++m) { const f32x4 g = acc[ai][0][m][n], v = acc[ai][1][m][n]; f32x4 o;
#pragma unroll
                        for (int k = 0; k < 4; ++k) { const float x = g[k]; const float e = __builtin_amdgcn_exp2f(-x * (2.3022082f + 0.10294324f * x * x)); o[k] = x * v[k] * __builtin_amdgcn_rcpf(1.0f + e); }
                        asm volatile("" : "+v"(o));
                        acc[ai][0][m][n] = o; }
            }
        }
        const int row0 = u.pm * BM + wr * 64 + fr;
#pragma unroll
        for (int ai = 0; ai < 2; ++ai)
#pragma unroll
            for (int m = 0; m < 4; ++m) { const f32x4 a = acc[ai][0][m][0], b = acc[ai][0][m][1];
                u32x4 w; w.x = cvt_pk_bf16(a[0], a[1]); w.y = cvt_pk_bf16(a[2], a[3]); w.z = cvt_pk_bf16(b[0], b[1]); w.w = cvt_pk_bf16(b[2], b[3]);
                *(u32x4*)(act + (size_t)(row0 + ai * HALF + m * 16) * ldact + chb) = w; }
    }
};
template <class Epi, class Sched, bool ALIGN_EPI = false, bool SP2 = false>
__device__ __forceinline__ void gemm_phase(PG8_LAS unsigned char* lds, const Gemm g, const Sched& S, const Epi& E) {
    int tid_l = threadIdx.x; asm volatile("" : "+v"(tid_l));
    const int tid = tid_l, wid = __builtin_amdgcn_readfirstlane(tid >> 6), lane = tid & 63, wr = wid >> 2, wc = wid & 3, fr = lane & 15, fq = lane >> 4;
    const int K = g.K, nt = K / BK;
    unsigned voffA[2], voffB[2];
#pragma unroll
    for (int i = 0; i < 2; ++i) { int R, C; stage_rc(tid * 16 + i * 8192, R, C); const int Rb = Epi::PERM ? ((R & ~31) + perm32(R & 31)) : R;
        voffA[i] = (unsigned)(R * g.lda + C) * 2u; voffB[i] = (unsigned)(Rb * K + C) * 2u; }
    const size_t kstep = (size_t)(BK * 2);
    const size_t hstep = (size_t)HALF * K * 2; const size_t hstepA = (size_t)HALF * g.lda * 2; const size_t tstepA = 2 * hstepA;
    const size_t tstep = 2 * hstep;
    const unsigned ldsw = (unsigned)wid * 1024u;
    const int aoff = lds_byte(wr * 64 + fr, fq * 8), boff = lds_byte(wc * 32 + fr, fq * 8);
#define PG8_SA(b, h) (((b) * 2 + (h)) * HTB)
#define PG8_SB(b, h) ((4 + (b) * 2 + (h)) * HTB)
#define PG8_STAGE(bufoff, gbase, voff) do { _Pragma("unroll") for (int _i = 0; _i < 2; ++_i) \
        __builtin_amdgcn_global_load_lds((const unsigned*)((const char*)(gbase) + (voff)[_i]), (PG8_LAS unsigned*)(lds + (bufoff) + ldsw + _i * 8192), 16, 0, 0); } while (0)
#define PG8_LDA(dst, b, h) do { _Pragma("unroll") for (int m = 0; m < 4; ++m) _Pragma("unroll") for (int k = 0; k < 2; ++k) dst[m][k] = *(const PG8_LAS bf16x8*)(lds + PG8_SA(b, h) + aoff + m * 2048 + k * 1024); } while (0)
#define PG8_LDB(dst, b, h) do { _Pragma("unroll") for (int n = 0; n < 2; ++n) _Pragma("unroll") for (int k = 0; k < 2; ++k) dst[n][k] = *(const PG8_LAS bf16x8*)(lds + PG8_SB(b, h) + boff + n * 2048 + k * 1024); } while (0)
#define PG8_MMA(ai, bj, At, Bt) do { __builtin_amdgcn_s_setprio(1); _Pragma("unroll") for (int m = 0; m < 4; ++m) _Pragma("unroll") for (int n = 0; n < 2; ++n) _Pragma("unroll") for (int k = 0; k < 2; ++k) \
        acc[ai][bj][m][n] = __builtin_amdgcn_mfma_f32_16x16x32_bf16(Bt[n][k], At[m][k], acc[ai][bj][m][n], 0, 0, 0); __builtin_amdgcn_s_setprio(0); } while (0)
#define PG8_WAIT_V(n) asm volatile("s_waitcnt vmcnt(" #n ")" ::: "memory")
#define PG8_WAIT_L(n) asm volatile("s_waitcnt lgkmcnt(" #n ")" ::: "memory")
#define PG8_BAR __builtin_amdgcn_s_barrier()
#define PG8_SCHED __builtin_amdgcn_sched_barrier(0)
    Unit cur, nxt; int ui = 0;
    if (!S.next(0, cur)) return;
    f32x4 acc[2][2][4][2];
#pragma unroll
    for (int a = 0; a < 2; ++a)
#pragma unroll
        for (int b = 0; b < 2; ++b)
#pragma unroll
            for (int m = 0; m < 4; ++m)
#pragma unroll
                for (int n = 0; n < 2; ++n) acc[a][b][m][n] = (f32x4){0.f, 0.f, 0.f, 0.f};
    bf16x8 At[4][2], B0[2][2], B1[2][2];
    const char* cA = (const char*)g.A + (size_t)cur.pm * tstepA + (size_t)(cur.pn & 1) * g.aalt; const char* cB = (const char*)g.Bt + (size_t)cur.pn * tstep;
    S.a_ready(cur);
    if constexpr (SP2) {
        PG8_STAGE(PG8_SB(0, 0), cB, voffB); PG8_STAGE(PG8_SB(0, 1), cB + hstep, voffB); PG8_STAGE(PG8_SA(0, 0), cA, voffA); PG8_STAGE(PG8_SA(0, 1), cA + hstepA, voffA);
        if (wr == 1) PG8_BAR;
        PG8_WAIT_V(2); PG8_BAR;
        PG8_STAGE(PG8_SB(1, 0), cB + kstep, voffB); PG8_STAGE(PG8_SA(1, 0), cA + kstep, voffA); PG8_STAGE(PG8_SB(1, 1), cB + hstep + kstep, voffB);
        PG8_WAIT_V(6); PG8_BAR;
    } else {
        PG8_STAGE(PG8_SB(0, 0), cB, voffB); PG8_STAGE(PG8_SA(0, 0), cA, voffA); PG8_STAGE(PG8_SB(0, 1), cB + hstep, voffB); PG8_STAGE(PG8_SA(0, 1), cA + hstepA, voffA);
        if (wr == 1) PG8_BAR;
        PG8_WAIT_V(4); PG8_BAR;
        PG8_STAGE(PG8_SB(1, 0), cB + kstep, voffB); PG8_STAGE(PG8_SA(1, 0), cA + kstep, voffA); PG8_STAGE(PG8_SB(1, 1), cB + hstep + kstep, voffB);
        PG8_WAIT_V(6); PG8_BAR;
    }
    for (;;) {
        const bool has_next = S.next(ui + 1, nxt);
        const char* nA = has_next ? (const char*)g.A + (size_t)nxt.pm * tstepA + (size_t)(nxt.pn & 1) * g.aalt : cA; const char* nB = has_next ? (const char*)g.Bt + (size_t)nxt.pn * tstep : cB;
        for (int t = 0; t < nt; t += 2) {
            const bool last = (t == nt - 2);
            const char* a1 = cA + (size_t)(t + 1) * kstep;
            const char* a2 = last ? nA : cA + (size_t)(t + 2) * kstep; const char* b2 = last ? nB : cB + (size_t)(t + 2) * kstep;
            const char* a3 = a2 + kstep; const char* b3 = b2 + kstep;
            if (last && has_next) S.a_ready(nxt);
            if constexpr (SP2) {
            PG8_LDB(B0, 0, 0); PG8_LDB(B1, 0, 1); PG8_SCHED; PG8_LDA(At, 0, 0); PG8_STAGE(PG8_SA(1, 1), a1 + hstepA, voffA);
            PG8_WAIT_V(8); PG8_WAIT_L(0); PG8_BAR; PG8_MMA(0, 0, At, B0); PG8_MMA(0, 1, At, B1); PG8_BAR; PG8_SCHED;
            PG8_LDA(At, 0, 1); PG8_STAGE(PG8_SB(0, 0), b2, voffB); PG8_STAGE(PG8_SB(0, 1), b2 + hstep, voffB); PG8_STAGE(PG8_SA(0, 0), a2, voffA);
            PG8_WAIT_V(8); PG8_WAIT_L(0); PG8_BAR; PG8_MMA(1, 0, At, B0); PG8_MMA(1, 1, At, B1); PG8_BAR; PG8_SCHED;
            PG8_LDB(B0, 1, 0); PG8_LDB(B1, 1, 1); PG8_SCHED; PG8_LDA(At, 1, 0); PG8_STAGE(PG8_SA(0, 1), a2 + hstepA, voffA);
            PG8_WAIT_V(8); PG8_WAIT_L(0); PG8_BAR; PG8_MMA(0, 0, At, B0); PG8_MMA(0, 1, At, B1); PG8_BAR; PG8_SCHED;
            PG8_LDA(At, 1, 1); PG8_STAGE(PG8_SB(1, 0), b3, voffB); PG8_STAGE(PG8_SB(1, 1), b3 + hstep, voffB); PG8_STAGE(PG8_SA(1, 0), a3, voffA);
            PG8_WAIT_V(8); PG8_WAIT_L(0); PG8_BAR; PG8_MMA(1, 0, At, B0); PG8_MMA(1, 1, At, B1); PG8_BAR; PG8_SCHED;
            } else {
            PG8_LDB(B0, 0, 0); PG8_SCHED; PG8_LDA(At, 0, 0); PG8_STAGE(PG8_SA(1, 1), a1 + hstepA, voffA);
            PG8_WAIT_L(8); PG8_BAR; PG8_WAIT_L(0); PG8_MMA(0, 0, At, B0); PG8_BAR; PG8_SCHED;
            PG8_LDB(B1, 0, 1); PG8_STAGE(PG8_SB(0, 0), b2, voffB);
            PG8_BAR; PG8_WAIT_L(0); PG8_MMA(0, 1, At, B1); PG8_BAR;
            PG8_LDA(At, 0, 1); PG8_STAGE(PG8_SA(0, 0), a2, voffA);
            PG8_BAR; PG8_WAIT_L(0); PG8_MMA(1, 0, At, B0); PG8_BAR; PG8_SCHED;
            PG8_STAGE(PG8_SB(0, 1), b2 + hstep, voffB);
            PG8_WAIT_V(6); PG8_BAR; PG8_MMA(1, 1, At, B1); PG8_BAR;
            PG8_LDB(B0, 1, 0); PG8_SCHED; PG8_LDA(At, 1, 0); PG8_STAGE(PG8_SA(0, 1), a2 + hstepA, voffA);
            PG8_WAIT_L(8); PG8_BAR; PG8_WAIT_L(0); PG8_MMA(0, 0, At, B0); PG8_BAR; PG8_SCHED;
            PG8_LDB(B1, 1, 1); PG8_STAGE(PG8_SB(1, 0), b3, voffB);
            PG8_BAR; PG8_WAIT_L(0); PG8_MMA(0, 1, At, B1); PG8_BAR;
            PG8_LDA(At, 1, 1); PG8_STAGE(PG8_SA(1, 0), a3, voffA);
            PG8_BAR; PG8_WAIT_L(0); PG8_MMA(1, 0, At, B0); PG8_BAR; PG8_SCHED;
            PG8_STAGE(PG8_SB(1, 1), b3 + hstep, voffB);
            PG8_WAIT_V(6); PG8_BAR; PG8_MMA(1, 1, At, B1); PG8_BAR;
            }
        }
        if constexpr (ALIGN_EPI) { if (wr == 0) PG8_BAR; }
        if constexpr (!Epi::AFTER_DRAIN) { E(acc, cur, wr, wc, fr, fq); S.done(cur); }
        if (!has_next) break;
#pragma unroll
        for (int a = 0; a < 2; ++a)
#pragma unroll
            for (int b = 0; b < 2; ++b)
#pragma unroll
                for (int m = 0; m < 4; ++m)
#pragma unroll
                    for (int n = 0; n < 2; ++n) acc[a][b][m][n] = (f32x4){0.f, 0.f, 0.f, 0.f};
        cur = nxt; cA = nA; cB = nB; ++ui;
        if constexpr (ALIGN_EPI) { if (wr == 1) PG8_BAR; }
    }
    PG8_WAIT_V(0);
    if constexpr (!ALIGN_EPI) { if (wr == 0) PG8_BAR; }
    PG8_BAR;
    if constexpr (Epi::AFTER_DRAIN) { E.fused(acc, cur, wr, wc, fr, fq, lds, wid, lane); S.done(cur); }
#undef PG8_SA
#undef PG8_SB
#undef PG8_STAGE
#undef PG8_LDA
#undef PG8_LDB
#undef PG8_MMA
#undef PG8_WAIT_V
#undef PG8_WAIT_L
#undef PG8_BAR
#undef PG8_SCHED
}
}
#define LAS __attribute__((address_space(3)))
typedef unsigned short bf16;
typedef unsigned v4u __attribute__((ext_vector_type(4)));
typedef unsigned v2u __attribute__((ext_vector_type(2)));
typedef float f32x4 __attribute__((ext_vector_type(4)));
typedef float f32x16 __attribute__((ext_vector_type(16)));
typedef short bf16x8 __attribute__((ext_vector_type(8)));
typedef short v4i16_t __attribute__((ext_vector_type(4)));
constexpr int NB = 8, S_ = 2048, D_ = 2048, T_ = NB * S_;
constexpr int NP = 11776;
constexpr int NIN = 11600;
constexpr int C_LX = 0, C_LG = 2048, C_Q = 4096, C_K = 6144, C_V = 6272, C_QI = 6400, C_KI = 7424, C_WI = 7488, C_GL = 7680, C_GA = 9728;
constexpr int FF = 6144, FF2 = 12288;
constexpr float LN_EPS = 1e-5f;
constexpr float ALPHA = 1.189207115f;
constexpr size_t MiB = 1u << 20;
constexpr size_t WS_WINT = 0, WS_XB = 48 * MiB;
constexpr size_t WS_WLA = 0, WS_WOUT = 16 * MiB, WS_WUP = 24 * MiB, WS_WDN = 72 * MiB;
constexpr size_t WS_PROJ = 112 * MiB;
constexpr size_t WS_KIN = 480 * MiB;
constexpr size_t WS_H1B = 112 * MiB, WS_ACT = 176 * MiB, WS_HEAD = 368 * MiB, WS_TAIL = 400 * MiB;
constexpr size_t WS_END = 482 * MiB;
constexpr int LDS_BYTES = 147456;

__device__ __forceinline__ float bf_lo(unsigned u) { return __uint_as_float(u << 16); }
__device__ __forceinline__ float bf_hi(unsigned u) { return __uint_as_float(u & 0xffff0000u); }
__device__ __forceinline__ float bf1(bf16 h) { return __uint_as_float(((unsigned)h) << 16); }
__device__ __forceinline__ unsigned f2bf(float f) { unsigned u = __float_as_uint(f); return (u + 0x7fffu + ((u >> 16) & 1u)) >> 16; }
__device__ __forceinline__ unsigned pk2(float lo, float hi) { return pg8::cvt_pk_bf16(lo, hi); }
__device__ __forceinline__ float sigmoidf_(float x) { return __builtin_amdgcn_rcpf(1.0f + __expf(-x)); }
__device__ __forceinline__ float gelu_t(float x) { const float e = __builtin_amdgcn_exp2f(-x * (2.3022082f + 0.10294324f * x * x)); return x * __builtin_amdgcn_rcpf(1.0f + e); }
__device__ __forceinline__ float wave_sum(float v) {
#pragma unroll
    for (int o = 1; o < 64; o <<= 1) v += __shfl_xor(v, o);
    return v;
}
struct P {
    const float *x, *w_in, *lru_conv_w, *lru_conv_b, *ga_w, *ga_b, *gx_w, *gx_b, *lam, *kn_g, *kn_b, *rel_bias, *w_pl, *w_pa, *w_out, *ln1_g, *ln1_b, *w_up, *fc_w, *fc_b, *w_dn, *ln2_g, *ln2_b;
    float* out; unsigned char* ws;
};
template <class MapN>
__device__ __forceinline__ void transpose_item(const float* W, int N, bf16* WT, int ldk, int koff, LAS float* scr, int kb, int nb, int lane, MapN map) {
    const int k0 = 64 * kb, n0 = 32 * nb; const int nn = n0 + (lane & 31);
#pragma unroll 8
    for (int i = 0; i < 32; ++i) { const int kk = 2 * i + (lane >> 5); scr[kk * 33 + (lane & 31)] = nn < N ? W[(size_t)(k0 + kk) * N + nn] : 0.f; }
    asm volatile("s_waitcnt lgkmcnt(0)" ::: "memory");
    const int c = lane & 7;
#pragma unroll
    for (int j = 0; j < 4; ++j) { const int n = (lane >> 3) + 8 * j; const LAS float* s = scr + (8 * c) * 33 + n;
        v4u o; o.x = pk2(s[0 * 33], s[1 * 33]); o.y = pk2(s[2 * 33], s[3 * 33]); o.z = pk2(s[4 * 33], s[5 * 33]); o.w = pk2(s[6 * 33], s[7 * 33]);
        if (n0 + n < N) *(v4u*)(WT + (size_t)map(n0 + n) * ldk + koff + k0 + 8 * c) = o; }
    asm volatile("s_waitcnt lgkmcnt(0)" ::: "memory");
}
struct MapId { __device__ __forceinline__ int operator()(int n) const { return n; } };
struct MapPair { int sel; __device__ __forceinline__ int operator()(int n) const { return 512 * (n >> 8) + 256 * sel + (n & 255); } };
struct MapIn { __device__ __forceinline__ int operator()(int n) const { return n < 7504 ? n : n + 176; } };
struct MapUp { __device__ __forceinline__ int operator()(int n) const { const int v = n >= FF ? 1 : 0, j = n - v * FF; return 256 * (j >> 7) + 128 * v + (j & 127); } };

__device__ __forceinline__ void phase0(const P& p, LAS unsigned char* lds, int gw, int NGW, int lane, int wave) {
    LAS float* scr = (LAS float*)(lds + wave * 16384);
    bf16* winT = (bf16*)(p.ws + WS_WINT);
    constexpr int NBLK = (NIN + 31) / 32;
    for (int it = gw; it < 32 * NBLK; it += NGW) transpose_item(p.w_in, NIN, winT, D_, 0, scr, it / NBLK, it % NBLK, lane, MapIn());
    for (int i = gw * 64 + lane; i < 176 * D_ / 8; i += NGW * 64) *(v4u*)(winT + (size_t)7504 * D_ + (size_t)i * 8) = (v4u){0u, 0u, 0u, 0u};
    bf16* xb = (bf16*)(p.ws + WS_XB);
    for (size_t i = (size_t)gw * 64 + lane; i < (size_t)T_ * D_ / 8; i += (size_t)NGW * 64) {
        const f32x4 a = *(const f32x4*)(p.x + i * 8), b = *(const f32x4*)(p.x + i * 8 + 4);
        v4u o; o.x = pk2(a[0], a[1]); o.y = pk2(a[2], a[3]); o.z = pk2(b[0], b[1]); o.w = pk2(b[2], b[3]);
        *(v4u*)(xb + i * 8) = o; }
}
__device__ __forceinline__ void phase15(const P& p, LAS unsigned char* lds, int gw, int NGW, int lane, int wave) {
    LAS float* scr = (LAS float*)(lds + wave * 16384);
    bf16* wla = (bf16*)(p.ws + WS_WLA); bf16* wout = (bf16*)(p.ws + WS_WOUT); bf16* wup = (bf16*)(p.ws + WS_WUP); bf16* wdn = (bf16*)(p.ws + WS_WDN);
    constexpr int I_SQ = 32 * 64, I_UP = 32 * (FF2 / 32), I_DN = (FF / 64) * 64;
    constexpr int NIT = 3 * I_SQ + I_UP + I_DN;
    for (int it = gw; it < NIT; it += NGW) {
        int r = it;
        if (r < I_SQ) { transpose_item(p.w_pl, D_, wla, D_, 0, scr, r / 64, r % 64, lane, MapPair{0}); continue; } r -= I_SQ;
        if (r < I_SQ) { transpose_item(p.w_pa, D_, wla, D_, 0, scr, r / 64, r % 64, lane, MapPair{1}); continue; } r -= I_SQ;
        if (r < I_SQ) { transpose_item(p.w_out, D_, wout, D_, 0, scr, r / 64, r % 64, lane, MapId()); continue; } r -= I_SQ;
        if (r < I_UP) { transpose_item(p.w_up, FF2, wup, D_, 0, scr, r / (FF2 / 32), r % (FF2 / 32), lane, MapUp()); continue; } r -= I_UP;
        transpose_item(p.w_dn, D_, wdn, FF, 0, scr, r / 64, r % 64, lane, MapId());
    }
    const bf16* proj = (const bf16*)(p.ws + WS_PROJ); bf16* kin = (bf16*)(p.ws + WS_KIN);
    const float g = p.kn_g[lane], bta = p.kn_b[lane];
    for (int t = gw; t < T_; t += NGW) {
        const float v = bf1(proj[(size_t)t * NP + C_KI + lane]);
        const float mu = wave_sum(v) * (1.f / 64.f); const float d = v - mu; const float var = wave_sum(d * d) * (1.f / 64.f);
        kin[(size_t)t * 64 + lane] = (bf16)f2bf(d * __builtin_amdgcn_rsqf(var + LN_EPS) * g + bta);
    }
}
__device__ __forceinline__ void ln_rows(float* io, bf16* ob, const float* gam, const float* bet, int gw, int NGW, int lane) {
    for (int t = gw; t < T_; t += NGW) {
        f32x4* r = (f32x4*)(io + (size_t)t * D_) + lane; f32x4 v[8]; float s = 0.f;
#pragma unroll
        for (int j = 0; j < 8; ++j) { v[j] = r[64 * j]; s += (v[j][0] + v[j][1]) + (v[j][2] + v[j][3]); }
        const float mu = wave_sum(s) * (1.f / D_); float q = 0.f;
#pragma unroll
        for (int j = 0; j < 8; ++j) { v[j] = v[j] - mu; q += (v[j][0] * v[j][0] + v[j][1] * v[j][1]) + (v[j][2] * v[j][2] + v[j][3] * v[j][3]); }
        const float rstd = 1.0f / sqrtf(wave_sum(q) * (1.f / D_) + LN_EPS);
#pragma unroll
        for (int j = 0; j < 8; ++j) { const f32x4 g = *((const f32x4*)gam + lane + 64 * j), b = *((const f32x4*)bet + lane + 64 * j); const f32x4 o = v[j] * rstd * g + b; r[64 * j] = o;
            if (ob) { v2u w; w.x = pk2(o[0], o[1]); w.y = pk2(o[2], o[3]); *(v2u*)(ob + (size_t)t * D_ + 4 * (lane + 64 * j)) = w; } }
    }
}
__device__ __forceinline__ void ffn_fixup(const P& p, int gtid, int NT) {
    const float* head = (const float*)(p.ws + WS_HEAD); const float* tail = (const float*)(p.ws + WS_TAIL); bf16* act = (bf16*)(p.ws + WS_ACT);
    for (int i = gtid; i < (T_ / 64) * 2 * FF; i += NT) {
        const int j = i % FF, gr = i / FF, r = gr & 1, G = gr >> 1; const int tc = 256 * (j >> 7) + (j & 127);
        const bool first = (G & 31) == 0;
        float o2[2];
#pragma unroll
        for (int v = 0; v < 2; ++v) { const int c = tc + 128 * v, ch = j + v * FF;
            const float h0 = head[((size_t)G * 2 + 0) * FF2 + c], h1 = head[((size_t)G * 2 + 1) * FF2 + c];
            const float t0 = first ? 0.f : tail[((size_t)(G - 1) * 2 + 0) * FF2 + c], t1 = first ? 0.f : tail[((size_t)(G - 1) * 2 + 1) * FF2 + c];
            const float x0 = r ? h1 : h0, x1 = r ? h0 : t1, x2 = r ? t1 : t0;
            o2[v] = p.fc_b[ch] + p.fc_w[ch] * x2 + p.fc_w[FF2 + ch] * x1 + p.fc_w[2 * FF2 + ch] * x0; }
        act[(size_t)(G * 64 + r) * FF + j] = (bf16)f2bf(gelu_t(o2[0]) * o2[1]);
    }
}
__device__ __forceinline__ void lru_unit(const P& p, LAS unsigned char* lds, int u, int tid, int lane, int wave) {
    constexpr int XA_P = 272;
    constexpr int GT_P = 132;
    LAS unsigned char* XA = lds;
    LAS float* XC = (LAS float*)(lds + 34816);
    LAS float* GT = (LAS float*)(lds + 67584);
    LAS float* SEGA = (LAS float*)(lds + 135168);
    LAS float* SEGH = SEGA + 512;
    LAS float* CAR = SEGH + 512;
    const int b = u >> 5, n = (u & 31) >> 1, half = u & 1, cin0 = 128 * n, cout0 = cin0 + 64 * half;
    bf16* proj = (bf16*)(p.ws + WS_PROJ);
    const int fr = lane & 15, fq = lane >> 4;
    bf16x8 Bf[4];
    { const float* Wg = (wave < 4 ? p.ga_w : p.gx_w) + (size_t)n * 128 * 128 + 64 * half + 16 * (wave & 3) + fr;
#pragma unroll
      for (int s = 0; s < 4; ++s) { unsigned w[4];
#pragma unroll
          for (int jj = 0; jj < 4; ++jj) w[jj] = pk2(Wg[(size_t)(32 * s + 8 * fq + 2 * jj) * 128], Wg[(size_t)(32 * s + 8 * fq + 2 * jj + 1) * 128]);
          Bf[s] = __builtin_bit_cast(bf16x8, (v4u){w[0], w[1], w[2], w[3]}); } }
    const int c = tid & 63, seg = tid >> 6;
    const float ba = p.ga_b[cout0 + c], bx = p.gx_b[cout0 + c];
    const float sp8 = -8.0f * log1pf(__expf(-p.lam[cout0 + c]));
    if (tid < 128) CAR[tid] = 0.f;
    const int cg8 = tid & 15, tg = tid >> 4;
    for (int ch = 0; ch < S_ / 128; ++ch) {
        const int tc0 = ch * 128;
        {
            float wj[4][8], bb[8];
#pragma unroll
            for (int j = 0; j < 4; ++j) { const f32x4 a = *(const f32x4*)(p.lru_conv_w + j * D_ + cin0 + 8 * cg8), d = *(const f32x4*)(p.lru_conv_w + j * D_ + cin0 + 8 * cg8 + 4);
#pragma unroll
                for (int e = 0; e < 4; ++e) { wj[j][e] = a[e]; wj[j][4 + e] = d[e]; } }
            { const f32x4 a = *(const f32x4*)(p.lru_conv_b + cin0 + 8 * cg8), d = *(const f32x4*)(p.lru_conv_b + cin0 + 8 * cg8 + 4);
#pragma unroll
              for (int e = 0; e < 4; ++e) { bb[e] = a[e]; bb[4 + e] = d[e]; } }
            float xr[7][8];
#pragma unroll
            for (int r = 0; r < 7; ++r) { const int t = tc0 + 4 * tg - 3 + r;
                v4u raw = (v4u){0u, 0u, 0u, 0u};
                if (t >= 0) raw = *(const v4u*)(proj + (size_t)(b * S_ + t) * NP + C_LX + cin0 + 8 * cg8);
#pragma unroll
                for (int k = 0; k < 4; ++k) { xr[r][2 * k] = bf_lo(raw[k]); xr[r][2 * k + 1] = bf_hi(raw[k]); } }
#pragma unroll
            for (int q = 0; q < 4; ++q) { float o[8];
#pragma unroll
                for (int e = 0; e < 8; ++e) o[e] = bb[e] + wj[0][e] * xr[q][e] + wj[1][e] * xr[q + 1][e] + wj[2][e] * xr[q + 2][e] + wj[3][e] * xr[q + 3][e];
                const int tok = 4 * tg + q;
                v4u w; w.x = pk2(o[0], o[1]); w.y = pk2(o[2], o[3]); w.z = pk2(o[4], o[5]); w.w = pk2(o[6], o[7]);
                *(LAS v4u*)(XA + tok * XA_P + cg8 * 16) = w;
                if ((cg8 >> 3) == half) { LAS float* xc = XC + tok * 64 + 8 * (cg8 & 7); *(LAS f32x4*)xc = (f32x4){o[0], o[1], o[2], o[3]}; *(LAS f32x4*)(xc + 4) = (f32x4){o[4], o[5], o[6], o[7]}; } }
        }
        bf16 lg[16];
#pragma unroll
        for (int k = 0; k < 16; ++k) lg[k] = proj[(size_t)(b * S_ + tc0 + 16 * seg + k) * NP + C_LG + cout0 + c];
        __syncthreads();
#pragma unroll
        for (int rt = 0; rt < 8; ++rt) { f32x4 acc = (f32x4){0.f, 0.f, 0.f, 0.f};
#pragma unroll
            for (int s = 0; s < 4; ++s) { const bf16x8 a = *(const LAS bf16x8*)(XA + (16 * rt + fr) * XA_P + (32 * s + 8 * fq) * 2); acc = __builtin_amdgcn_mfma_f32_16x16x32_bf16(a, Bf[s], acc, 0, 0, 0); }
#pragma unroll
            for (int i = 0; i < 4; ++i) GT[(16 * rt + 4 * fq + i) * GT_P + 16 * wave + fr] = acc[i]; }
        __syncthreads();
        float av[16], uv[16]; float hl = 0.f, Al = 1.f;
#pragma unroll
        for (int k = 0; k < 16; ++k) { const int tok = 16 * seg + k;
            const float r = sigmoidf_(GT[tok * GT_P + c] + ba), ii = sigmoidf_(GT[tok * GT_P + 64 + c] + bx);
            const float a = __expf(sp8 * r); float mult = sqrtf(fmaxf(1.0f - a * a, 0.f)); if (tc0 + tok == 0) mult = 1.0f;
            const float uu = mult * ii * XC[tok * 64 + c];
            av[k] = a; uv[k] = uu; hl = a * hl + uu; Al *= a; }
        SEGA[seg * 64 + c] = Al; SEGH[seg * 64 + c] = hl;
        __syncthreads();
        float cin = CAR[(ch & 1) * 64 + c];
        for (int s2 = 0; s2 < seg; ++s2) cin = SEGA[s2 * 64 + c] * cin + SEGH[s2 * 64 + c];
        if (seg == 7) CAR[((ch + 1) & 1) * 64 + c] = Al * cin + hl;
        float h = cin;
#pragma unroll
        for (int k = 0; k < 16; ++k) { h = av[k] * h + uv[k];
            proj[(size_t)(b * S_ + tc0 + 16 * seg + k) * NP + C_LG + cout0 + c] = (bf16)f2bf(gelu_t(bf1(lg[k])) * h); }
    }
    __syncthreads();
}
constexpr int A_VT = 0, VT_P = 288, A_LIST = 73728, A_BUCK = 81920, A_BIAS = 83968;
__device__ __forceinline__ unsigned offb(unsigned row, unsigned ch) { return 256u * row + 16u * (ch ^ (((row & 3) << 2) | ((row >> 2) & 3))); }
__device__ __forceinline__ void dsa_tables(const P& p, LAS unsigned char* lds, int tid) {
    LAS unsigned char* BUCK = lds + A_BUCK; LAS float* BIAS = (LAS float*)(lds + A_BIAS);
    for (int rel = tid; rel < S_; rel += 512) { int bk;
        if (rel < 16) bk = rel; else { const float nf = (float)rel; int lg = 16 + (int)(logf(nf / 16.0f) / 2.0794415416798357f * 16.0f); bk = lg < 31 ? lg : 31; }
        BUCK[rel] = (unsigned char)bk; }
    BIAS[tid] = p.rel_bias[tid];
    __syncthreads();
}
__device__ __forceinline__ void dsa_unit(const P& p, LAS unsigned char* lds, int b, int tg, int lane, int wave) {
    bf16* proj = (bf16*)(p.ws + WS_PROJ); const bf16* kin = (const bf16*)(p.ws + WS_KIN);
    LAS unsigned short* LIST = (LAS unsigned short*)(lds + A_LIST) + wave * 512;
    LAS unsigned char* VT = lds + A_VT + wave * (32 * VT_P);
    const LAS unsigned char* BUCK = lds + A_BUCK; const LAS float* BIAS = (const LAS float*)(lds + A_BIAS);
    const int t0 = 16 * tg + 2 * wave;
    const size_t rowb = (size_t)b * S_;
    unsigned scr[64];
#ifdef DSA_NOIDX
#pragma unroll
    for (int j = 0; j < 64; ++j) scr[j] = lane * j;
#else
    {
        const int r = lane & 31, kh = lane >> 5;
        const int atok = t0 + ((r >> 2) & 1), ahead = 4 * (r >> 3) + (r & 3);
        bf16x8 Aq[4];
        { const bf16* qp = proj + (rowb + atok) * NP + C_QI + ahead * 64 + 32 * kh;
#pragma unroll
          for (int s = 0; s < 4; ++s) Aq[s] = *(const bf16x8*)(qp + 8 * s); }
        float wv[16];
        { const bf16* wp = proj + (rowb + t0 + kh) * NP + C_WI; const v4u w0 = *(const v4u*)wp, w1 = *(const v4u*)(wp + 8);
#pragma unroll
          for (int k = 0; k < 4; ++k) { wv[2 * k] = bf_lo(w0[k]) * 0.03125f; wv[2 * k + 1] = bf_hi(w0[k]) * 0.03125f; wv[8 + 2 * k] = bf_lo(w1[k]) * 0.03125f; wv[9 + 2 * k] = bf_hi(w1[k]) * 0.03125f; } }
        const int mytok = t0 + kh;
        const int ngrp = (t0 + 1) / 256 + 1;
#pragma unroll
        for (int g8 = 0; g8 < 8; ++g8) {
            if (g8 < ngrp) {
                bf16x8 kb[2][4];
                const bf16* kp = kin + (rowb + 32 * (g8 * 8) + r) * 64 + 32 * kh;
                asm volatile("" : "+v"(kp));
#pragma unroll
                for (int s = 0; s < 4; ++s) kb[0][s] = *(const bf16x8*)(kp + 8 * s);
#pragma unroll
                for (int j = 0; j < 8; ++j) { const int blk = g8 * 8 + j, key = 32 * blk + r;
                    if (j < 7) { kp += 32 * 64; asm volatile("" : "+v"(kp));
#pragma unroll
                        for (int s = 0; s < 4; ++s) kb[(j + 1) & 1][s] = *(const bf16x8*)(kp + 8 * s); }
                    f32x16 acc;
#pragma unroll
                    for (int e = 0; e < 16; ++e) acc[e] = 0.f;
#pragma unroll
                    for (int s = 0; s < 4; ++s) acc = __builtin_amdgcn_mfma_f32_32x32x16_bf16(Aq[s], kb[j & 1][s], acc, 0, 0, 0);
                    float sc = 0.f;
#pragma unroll
                    for (int e = 0; e < 16; ++e) sc += wv[e] * fmaxf(acc[e], 0.f);
                    const unsigned ub = __float_as_uint(sc); const unsigned mono = ub ^ ((ub >> 31) ? 0xFFFFFFFFu : 0x80000000u);
                    unsigned sv = key <= mytok ? mono : 0u; asm volatile("" : "+v"(sv)); scr[blk] = sv;
                    __builtin_amdgcn_sched_barrier(0); }
            } else {
#pragma unroll
                for (int j = 0; j < 8; ++j) scr[g8 * 8 + j] = 0u;
            }
        }
    }
#endif
    {
        unsigned T = 0u;
        for (int bit = 31; bit >= 0; --bit) {
            const unsigned cand = T | (1u << bit); int clo = 0, chi = 0;
#pragma unroll
            for (int j = 0; j < 64; ++j) { const unsigned long long m = __ballot(scr[j] >= cand); clo += __popc((unsigned)m); chi += __popc((unsigned)(m >> 32)); }
            if ((lane < 32 ? clo : chi) >= 256) T = cand;
        }
        const unsigned Tm = T > 1u ? T : 1u;
        LAS unsigned short* mylist = LIST + (lane >> 5) * 256; int blo = 0, bhi = 0;
#pragma unroll
        for (int j = 0; j < 64; ++j) { const bool s = scr[j] >= Tm; const unsigned long long m = __ballot(s); const unsigned mlo = (unsigned)m, mhi = (unsigned)(m >> 32);
            const unsigned mm = lane < 32 ? mlo : mhi; const int pos = (lane < 32 ? blo : bhi) + __popc(mm & ((1u << (lane & 31)) - 1u));
            if (s && pos < 256) mylist[pos] = (unsigned short)(32 * j + (lane & 31));
            blo += __popc(mlo); bhi += __popc(mhi); }
        for (int q = (lane < 32 ? blo : bhi) + (lane & 31); q < 256; q += 32) mylist[q] = 0xFFFFu;
    }
    asm volatile("s_waitcnt lgkmcnt(0)" ::: "memory");
#ifndef DSA_NOATT
    int lane_a = lane; asm volatile("" : "+v"(lane_a));
    const int fr = lane_a & 15, fq = lane_a >> 4;
#pragma unroll 1
    for (int tt = 0; tt < 2; ++tt) {
        const int tok = t0 + tt; const LAS unsigned short* list = LIST + tt * 256;
        bf16x8 Qf[4];
        { const bf16* qp = proj + (rowb + tok) * NP + C_Q + fr * 128 + 32 * fq;
#pragma unroll
          for (int s = 0; s < 4; ++s) Qf[s] = *(const bf16x8*)(qp + 8 * s); }
        f32x4 sr[16];
#pragma unroll
        for (int gq = 0; gq < 4; ++gq) {
            bf16x8 kf[4][4];
#pragma unroll
            for (int g4 = 0; g4 < 4; ++g4) { const unsigned id = list[16 * (4 * gq + g4) + fr]; const unsigned key = id == 0xFFFFu ? 0u : id;
                const bf16* kp = proj + (rowb + key) * NP + C_K + 32 * fq;
#pragma unroll
                for (int s = 0; s < 4; ++s) kf[g4][s] = *(const bf16x8*)(kp + 8 * s); }
#pragma unroll
            for (int g4 = 0; g4 < 4; ++g4) {
#pragma unroll
                for (int s = 0; s < 4; ++s) asm volatile("" : "+v"(kf[g4][s]));
                f32x4 a = (f32x4){0.f, 0.f, 0.f, 0.f};
#pragma unroll
                for (int s = 0; s < 4; ++s) a = __builtin_amdgcn_mfma_f32_16x16x32_bf16(kf[g4][s], Qf[s], a, 0, 0, 0);
                asm volatile("" : "+v"(a)); sr[4 * gq + g4] = a; }
        }
        float mx = -INFINITY;
#ifndef DSA_NOSM
#pragma unroll
        for (int g = 0; g < 16; ++g) { const v2u i4 = *(const LAS v2u*)(list + 16 * g + 4 * fq);
#pragma unroll
            for (int i = 0; i < 4; ++i) { const unsigned id = (i & 1) ? (i4[i >> 1] >> 16) : (i4[i >> 1] & 0xffffu); const bool ok = id != 0xFFFFu;
                const int rel = ok ? tok - (int)id : 0; const int bk = BUCK[rel];
                const float lg = ok ? sr[g][i] * 0.08838834764831845f + BIAS[bk * 16 + fr] : -INFINITY; sr[g][i] = lg; mx = fmaxf(mx, lg); }
            if (g & 1) __builtin_amdgcn_sched_barrier(0); }
#endif
        mx = fmaxf(mx, __shfl_xor(mx, 16)); mx = fmaxf(mx, __shfl_xor(mx, 32));
        float sum = 0.f;
#pragma unroll
        for (int g = 0; g < 16; ++g)
#pragma unroll
            for (int i = 0; i < 4; ++i) { const float e = __expf(sr[g][i] - mx); sr[g][i] = e; sum += e; }
        sum += __shfl_xor(sum, 16); sum += __shfl_xor(sum, 32);
        const float inv = 1.0f / sum;
        v4u pbs[8];
#pragma unroll
        for (int c8 = 0; c8 < 8; ++c8) { pbs[c8].x = pk2(sr[2 * c8][0], sr[2 * c8][1]); pbs[c8].y = pk2(sr[2 * c8][2], sr[2 * c8][3]); pbs[c8].z = pk2(sr[2 * c8 + 1][0], sr[2 * c8 + 1][1]); pbs[c8].w = pk2(sr[2 * c8 + 1][2], sr[2 * c8 + 1][3]); asm volatile("" : "+v"(pbs[c8])); }
        f32x4 O[8];
#pragma unroll
        for (int c = 0; c < 8; ++c) O[c] = (f32x4){0.f, 0.f, 0.f, 0.f};
#ifndef DSA_NOPV
        LAS unsigned char* VTw = VT + fq * VT_P + fr * 16;
        LAS unsigned char* VTr = VT + (8 * fq + ((lane_a & 15) >> 2)) * VT_P + 8 * (lane_a & 3);
#pragma unroll
        for (int c8 = 0; c8 < 8; ++c8) {
            asm volatile("" ::: "memory");
            { v4u vreg[8];
#pragma unroll
              for (int i = 0; i < 8; ++i) { const int rho = 4 * i + fq;
                const unsigned id = list[16 * (2 * c8 + ((rho >> 2) & 1)) + 4 * (rho >> 3) + (rho & 3)]; const unsigned key = id == 0xFFFFu ? 0u : id;
                vreg[i] = *(const v4u*)(proj + (rowb + key) * NP + C_V + 8 * fr); }
#pragma unroll
              for (int i = 0; i < 8; ++i) { asm volatile("" : "+v"(vreg[i])); *(LAS v4u*)(VTw + i * (4 * VT_P)) = vreg[i]; } }
            asm volatile("s_waitcnt lgkmcnt(0)" ::: "memory");
            const bf16x8 pb = __builtin_bit_cast(bf16x8, pbs[c8]);
#pragma unroll
            for (int c = 0; c < 8; ++c) {
                const v4i16_t x0 = __builtin_amdgcn_ds_read_tr16_b64_v4i16((LAS v4i16_t*)(VTr + 32 * c)), x1 = __builtin_amdgcn_ds_read_tr16_b64_v4i16((LAS v4i16_t*)(VTr + 4 * VT_P + 32 * c));
                bf16x8 va; va[0] = x0[0]; va[1] = x0[1]; va[2] = x0[2]; va[3] = x0[3]; va[4] = x1[0]; va[5] = x1[1]; va[6] = x1[2]; va[7] = x1[3];
                O[c] = __builtin_amdgcn_mfma_f32_16x16x32_bf16(va, pb, O[c], 0, 0, 0); }
            asm volatile("s_waitcnt lgkmcnt(0)" ::: "memory");
        }
#endif
        bf16* op = proj + (rowb + tok) * NP + C_Q + fr * 128 + 4 * fq;
#pragma unroll
        for (int c = 0; c < 8; ++c) { v2u w; w.x = pk2(O[c][0] * inv, O[c][1] * inv); w.y = pk2(O[c][2] * inv, O[c][3] * inv); *(v2u*)(op + 16 * c) = w; }
    }
#endif
}
#ifndef PHM
#define PHM 0xFFFF
#endif
#define GEMM_PHASE(EpiT, g, E) do { pg8::StaticOrder S_; S_.init((g).M, (g).N, G, (int)blockIdx.x); pg8::gemm_phase<EpiT, pg8::StaticOrder, true, true>(lds, g, S_, E); } while (0)
__global__ void __launch_bounds__(512, 2) fwd_kernel(P p) {
    extern __shared__ __attribute__((aligned(16))) unsigned char lds_raw[];
    LAS unsigned char* lds = (LAS unsigned char*)lds_raw;
    cg::grid_group grid = cg::this_grid();
    const int G = gridDim.x, NGW = G * 8;
#define TIDS() int tid = threadIdx.x; asm volatile("" : "+v"(tid)); const int lane = tid & 63, wave = __builtin_amdgcn_readfirstlane(tid >> 6), gw = blockIdx.x * 8 + wave; (void)gw; (void)lane
    bf16* proj = (bf16*)(p.ws + WS_PROJ);
#if PHM & 1
    { TIDS(); phase0(p, lds, gw, NGW, lane, wave); }
#endif
    grid.sync();
#if PHM & 2
    { pg8::Gemm g{(const bf16*)(p.ws + WS_XB), (const bf16*)(p.ws + WS_WINT), T_, NP, D_, D_, 0}; pg8::EpiBf16<0> E{proj, NP, nullptr, 0, 0, 1.f}; GEMM_PHASE(pg8::EpiBf16<0>, g, E); }
#endif
    grid.sync();
#if PHM & 4
    { TIDS(); phase15(p, lds, gw, NGW, lane, wave); }
#endif
    grid.sync();
#if PHM & 8
    { TIDS(); for (int u = blockIdx.x; u < 256; u += G) lru_unit(p, lds, u, tid, lane, wave); }
#endif
#if PHM & 16
    { TIDS(); dsa_tables(p, lds, tid);
    for (int w = blockIdx.x; w < 256; w += G) { const int b = w >> 5, j = w & 31;
#pragma unroll 1
        for (int q = 0; q < 4; ++q) { const int tg = q == 0 ? j : q == 1 ? 63 - j : q == 2 ? 64 + j : 127 - j; dsa_unit(p, lds, b, tg, lane, wave); } } }
#endif
    grid.sync();
#if PHM & 32
    { pg8::Gemm g{proj + C_LG, (const bf16*)(p.ws + WS_WLA), T_, 2 * D_, D_, NP, (size_t)D_ * 2}; pg8::EpiMerge E{proj, NP, C_GL, C_GA, p.out, D_, proj, NP};
      pg8::PairOrder S_; S_.init(T_, D_, G, (int)blockIdx.x); pg8::gemm_phase<pg8::EpiMerge, pg8::PairOrder, true, true>(lds, g, S_, E); }
#endif
    grid.sync();
#if PHM & 64
    { pg8::Gemm g{proj, (const bf16*)(p.ws + WS_WOUT), T_, D_, D_, NP, 0}; pg8::EpiResid E{p.x, p.out, D_, ALPHA}; GEMM_PHASE(pg8::EpiResid, g, E); }
#endif
    grid.sync();
    { TIDS(); ln_rows(p.out, (bf16*)(p.ws + WS_H1B), p.ln1_g, p.ln1_b, gw, NGW, lane); }
    grid.sync();
#if PHM & 128
    { pg8::Gemm g{(const bf16*)(p.ws + WS_H1B), (const bf16*)(p.ws + WS_WUP), T_, FF2, D_, D_, 0}; pg8::EpiGeglu E{(bf16*)(p.ws + WS_ACT), FF, p.fc_w, p.fc_b, (float*)(p.ws + WS_HEAD), (float*)(p.ws + WS_TAIL), FF}; GEMM_PHASE(pg8::EpiGeglu, g, E); }
#endif
    grid.sync();
    { TIDS(); ffn_fixup(p, blockIdx.x * 512 + tid, G * 512); }
    grid.sync();
#if PHM & 256
    { pg8::Gemm g{(const bf16*)(p.ws + WS_ACT), (const bf16*)(p.ws + WS_WDN), T_, D_, FF, FF, 0}; pg8::EpiResid E{p.out, p.out, D_, ALPHA}; GEMM_PHASE(pg8::EpiResid, g, E); }
#endif
    grid.sync();
    { TIDS(); ln_rows(p.out, nullptr, p.ln2_g, p.ln2_b, gw, NGW, lane); }
}

extern "C" void kernel_launch(void* const* d_in, const int* in_sizes, int n_in, void* d_out, int out_size, void* d_ws, size_t ws_size, hipStream_t stream) {
    static int grid = 0;
    if (grid == 0) {
        if (n_in != 23 || out_size != T_ * D_ || ws_size < WS_END) { fprintf(stderr, "kernel_launch: unexpected shapes (n_in %d out %d ws %zu)\n", n_in, out_size, ws_size); grid = -1; return; }
        int dev = 0, cus = 0, per_cu = 0;
        (void)hipGetDevice(&dev); (void)hipDeviceGetAttribute(&cus, hipDeviceAttributeMultiprocessorCount, dev);
        (void)hipFuncSetAttribute((const void*)fwd_kernel, hipFuncAttributeMaxDynamicSharedMemorySize, LDS_BYTES);
        if (hipOccupancyMaxActiveBlocksPerMultiprocessor(&per_cu, (const void*)fwd_kernel, 512, LDS_BYTES) != hipSuccess || per_cu < 1) per_cu = 1;
        (void)hipGetLastError();
        grid = cus * per_cu;
    }
    if (grid < 0) return;
    P p{};
    const float** pp = (const float**)&p;
    for (int i = 0; i < 23; ++i) pp[i] = (const float*)d_in[i];
    p.out = (float*)d_out; p.ws = (unsigned char*)d_ws;
    void* args[] = {&p};
    hipError_t e = hipLaunchCooperativeKernel((const void*)fwd_kernel, dim3(grid), dim3(512), args, LDS_BYTES, stream);
    if (e != hipSuccess) fprintf(stderr, "cooperative launch failed: %s (grid %d)\n", hipGetErrorString(e), grid);
}
```

```cpp
#include <hip/hip_runtime.h>
#include <hip/hip_cooperative_groups.h>
#include <cstdio>
#include <cstdint>
namespace cg = cooperative_groups;
namespace pg8 {
#define PG8_LAS __attribute__((address_space(3)))
typedef unsigned short bf16_t;
typedef short bf16x8 __attribute__((ext_vector_type(8)));
typedef float f32x4 __attribute__((ext_vector_type(4)));
typedef unsigned u32x4 __attribute__((ext_vector_type(4)));
constexpr int BM = 256, BK = 64, HALF = 128, HTB = HALF * BK * 2  , STAGE_BYTES = 8 * HTB, NXCD = 8, WGM = 8;

__host__ __device__ __forceinline__ int lds_byte(int r, int c) { const int st = (r >> 4) * 2 + (c >> 5), rr = r & 15, cc = c & 31, ob = rr * 64 + cc * 2; return st * 1024 + (ob ^ (((ob >> 9) & 1) << 5)); }
__host__ __device__ __forceinline__ void stage_rc(int b, int& R, int& C) { const int st = b / 1024, sb = b % 1024, swz = sb ^ (((sb >> 9) & 1) << 5); R = (st >> 1) * 16 + swz / 64; C = (st & 1) * 32 + (swz % 64) / 2; }
__host__ __device__ __forceinline__ int perm32(int rho) { const int n = rho >> 4, i = rho & 15; return 8 * (i >> 2) + 4 * n + (i & 3); }

struct Unit { int pm, pn; };
struct Gemm { const bf16_t* A; const bf16_t* Bt; int M, N, K, lda; size_t aalt; };

struct StaticOrder {
    int nM, nN, nwg, G, c;
    __host__ __device__ void init(int M, int N, int G_, int c_) { nM = M / BM; nN = N / BM; nwg = nM * nN; G = G_; c = c_; }
    __host__ __device__ bool next(int i, Unit& u) const {
        const long L = (long)i * G + c; if (L >= nwg) return false;
        int wgid = (int)L; { const int q = nwg / NXCD, r = nwg % NXCD, xcd = wgid % NXCD, off = wgid / NXCD; wgid = (xcd < r ? xcd * (q + 1) : r * (q + 1) + (xcd - r) * q) + off; }
        const int nig = WGM * nN, gid = wgid / nig, fm = gid * WGM, gsz = (nM - fm) < WGM ? (nM - fm) : WGM;
        u.pm = fm + ((wgid % nig) % gsz); u.pn = (wgid % nig) / gsz; return true;
    }
    __device__ __forceinline__ void a_ready(const Unit&) const {}
    __device__ __forceinline__ void done(const Unit&) const {}
};

__device__ __forceinline__ unsigned cvt_pk_bf16(float lo, float hi) { unsigned r; asm volatile("v_cvt_pk_bf16_f32 %0, %1, %2" : "=v"(r) : "v"(lo), "v"(hi)); return r; }
typedef float f32x2 __attribute__((ext_vector_type(2)));
__device__ __forceinline__ f32x2 gelu_pk(f32x2 v) {
    const f32x2 av = __builtin_elementwise_abs(v), d = av * 0.2316418882f + 1.0f;
    f32x2 t; t.x = __builtin_amdgcn_rcpf(d.x); t.y = __builtin_amdgcn_rcpf(d.y);
    f32x2 q = t * 0.5307027145f + (-0.7265760135f); q = q * t + 0.7107068705f; q = q * t + (-0.142248368f); q = q * t + 0.127414796f; q = q * t;
    const f32x2 s = (v * v) * (-0.72134752044f);
    f32x2 e; e.x = __builtin_amdgcn_exp2f(s.x); e.y = __builtin_amdgcn_exp2f(s.y);
    const f32x2 m = v * (q * e), r = v - m;
    f32x2 o; o.x = v.x < 0.f ? m.x : r.x; o.y = v.y < 0.f ? m.y : r.y; return o;
}

template <int ACT  > struct EpiBf16 {
    static constexpr bool PERM = true, AFTER_DRAIN = false, MID = false; static_assert(ACT == 0 || ACT == 1, "EpiBf16: ACT is 0 (none) or 1 (gelu_pk)");
    bf16_t* O; int ldc; const float* bias; int split_cols; size_t split_stride; float scale0;
    __device__ __forceinline__ void operator()(const f32x4 (&acc)[2][2][4][2], const Unit& u, int wr, int wc, int fr, int fq) const {
        const int row0 = u.pm * BM + wr * 64 + fr; int colt = u.pn * BM; bf16_t* base = O;
        float sc = 1.f; if (split_cols) { const int t = colt / split_cols; base += (size_t)t * split_stride; colt -= t * split_cols; if (t == 0) sc = scale0; }
        const int col0 = colt + wc * 32 + 8 * fq, bcol0 = u.pn * BM + wc * 32 + 8 * fq;
        f32x4 bv[2][2];
#pragma unroll
        for (int bj = 0; bj < 2; ++bj)
#pragma unroll
            for (int n = 0; n < 2; ++n) bv[bj][n] = bias ? *(const f32x4*)(bias + bcol0 + bj * HALF + 4 * n) : (f32x4){0.f, 0.f, 0.f, 0.f};
#pragma unroll
        for (int ai = 0; ai < 2; ++ai)
#pragma unroll
            for (int m = 0; m < 4; ++m) { bf16_t* rowp = base + (size_t)(row0 + ai * HALF + m * 16) * ldc + col0;
#pragma unroll
                for (int bj = 0; bj < 2; ++bj) { f32x4 v0 = acc[ai][bj][m][0] + bv[bj][0], v1 = acc[ai][bj][m][1] + bv[bj][1];
                    if (ACT == 1) { f32x2 a = gelu_pk((f32x2){v0[0], v0[1]}), b = gelu_pk((f32x2){v0[2], v0[3]}), c = gelu_pk((f32x2){v1[0], v1[1]}), d = gelu_pk((f32x2){v1[2], v1[3]});
                        v0 = (f32x4){a.x, a.y, b.x, b.y}; v1 = (f32x4){c.x, c.y, d.x, d.y}; }
                    v0 = v0 * sc; v1 = v1 * sc; u32x4 w; w.x = cvt_pk_bf16(v0[0], v0[1]); w.y = cvt_pk_bf16(v0[2], v0[3]); w.z = cvt_pk_bf16(v1[0], v1[1]); w.w = cvt_pk_bf16(v1[2], v1[3]);
                    *(u32x4*)(rowp + bj * HALF) = w; } }
    }
};

__device__ __forceinline__ float blo(unsigned u) { return __uint_as_float(u << 16); }
__device__ __forceinline__ float bhi(unsigned u) { return __uint_as_float(u & 0xffff0000u); }
struct PairOrder {
    int nM, nN, nwg, G, c;
    __host__ __device__ void init(int M, int N, int G_, int c_) { nM = M / BM; nN = N / BM; nwg = nM * nN; G = G_; c = c_; }
    __host__ __device__ bool next(int i, Unit& u) const {
        const long L = (long)(i >> 1) * G + c; if (L >= nwg) return false;
        int wgid = (int)L; { const int q = nwg / NXCD, r = nwg % NXCD, xcd = wgid % NXCD, off = wgid / NXCD; wgid = (xcd < r ? xcd * (q + 1) : r * (q + 1) + (xcd - r) * q) + off; }
        const int nig = WGM * nN, gid = wgid / nig, fm = gid * WGM, gsz = (nM - fm) < WGM ? (nM - fm) : WGM;
        u.pm = fm + ((wgid % nig) % gsz); u.pn = 2 * ((wgid % nig) / gsz) + (i & 1); return true;
    }
    __device__ __forceinline__ void a_ready(const Unit&) const {}
    __device__ __forceinline__ void done(const Unit&) const {}
};
struct EpiMerge {
    static constexpr bool PERM = true, AFTER_DRAIN = false, MID = false;
    const bf16_t* G; int ldg, cgl, cga; float* tmp; int ldt; bf16_t* O; int ldc;
    __device__ __forceinline__ void operator()(f32x4 (&acc)[2][2][4][2], const Unit& u, int wr, int wc, int fr, int fq) const {
        const int sel = u.pn & 1; const int row0 = u.pm * BM + wr * 64 + fr, col0 = (u.pn >> 1) * BM + wc * 32 + 8 * fq; const int cg = sel ? cga : cgl;
        u32x4 L[2][2];
        { const bf16_t* rowp = G + (size_t)row0 * ldg + col0 + cg; L[0][0] = *(const u32x4*)(rowp); L[0][1] = *(const u32x4*)(rowp + HALF); }
#pragma unroll
        for (int idx = 0; idx < 8; ++idx) { const int ai = idx >> 2, m = idx & 3; const size_t r = (size_t)(row0 + ai * HALF + m * 16);
            if (idx < 7) { const int ai2 = (idx + 1) >> 2, m2 = (idx + 1) & 3; const bf16_t* rowp = G + (size_t)(row0 + ai2 * HALF + m2 * 16) * ldg + col0 + cg;
                L[(idx + 1) & 1][0] = *(const u32x4*)(rowp); L[(idx + 1) & 1][1] = *(const u32x4*)(rowp + HALF); }
#pragma unroll
            for (int bj = 0; bj < 2; ++bj) { u32x4 ga = L[idx & 1][bj];
                asm volatile("" : "+v"(ga));
                f32x4 o0, o1;
#pragma unroll
                for (int k = 0; k < 4; ++k) { const unsigned a = ga[k];
                    const float s0 = __builtin_amdgcn_rcpf(1.0f + __expf(-blo(a))), s1 = __builtin_amdgcn_rcpf(1.0f + __expf(-bhi(a)));
                    if (k < 2) { o0[2 * k] = acc[ai][bj][m][0][2 * k] * s0; o0[2 * k + 1] = acc[ai][bj][m][0][2 * k + 1] * s1; }
                    else { o1[2 * k - 4] = acc[ai][bj][m][1][2 * k - 4] * s0; o1[2 * k - 3] = acc[ai][bj][m][1][2 * k - 3] * s1; } }
                float* tp = tmp + r * ldt + col0 + bj * HALF;
                if (sel == 0) { *(f32x4*)tp = o0; *(f32x4*)(tp + 4) = o1; }
                else { const f32x4 t0 = *(const f32x4*)tp, t1 = *(const f32x4*)(tp + 4); o0 += t0; o1 += t1;
                    u32x4 w; w.x = cvt_pk_bf16(o0[0], o0[1]); w.y = cvt_pk_bf16(o0[2], o0[3]); w.z = cvt_pk_bf16(o1[0], o1[1]); w.w = cvt_pk_bf16(o1[2], o1[3]);
                    *(u32x4*)(O + r * ldc + col0 + bj * HALF) = w; } } }
    }
};
struct EpiResid {
    static constexpr bool PERM = false, AFTER_DRAIN = false, MID = false;
    const float* base; float* out; int ldc; float alpha;
    __device__ __forceinline__ void operator()(f32x4 (&acc)[2][2][4][2], const Unit& u, int wr, int wc, int fr, int fq) const {
        const int row0 = u.pm * BM + wr * 64 + fr, col0 = u.pn * BM + wc * 32 + 4 * fq;
#pragma unroll
        for (int ai = 0; ai < 2; ++ai)
#pragma unroll
            for (int m = 0; m < 4; ++m) { const size_t off = (size_t)(row0 + ai * HALF + m * 16) * ldc + col0;
#pragma unroll
                for (int bj = 0; bj < 2; ++bj)
#pragma unroll
                    for (int n = 0; n < 2; ++n) { const f32x4 bs = *(const f32x4*)(base + off + bj * HALF + n * 16); *(f32x4*)(out + off + bj * HALF + n * 16) = bs * alpha + acc[ai][bj][m][n]; } }
    }
};
__device__ __forceinline__ float dpp_prev1(float cur, float prev) {
    const int o = __builtin_amdgcn_update_dpp(0, __builtin_bit_cast(int, prev), 0x10F, 0xf, 0xf, true);
    return __builtin_bit_cast(float, __builtin_amdgcn_update_dpp(o, __builtin_bit_cast(int, cur), 0x111, 0xf, 0xf, false));
}
__device__ __forceinline__ float dpp_prev2(float cur, float prev) {
    const int o = __builtin_amdgcn_update_dpp(0, __builtin_bit_cast(int, prev), 0x10E, 0xf, 0xf, true);
    return __builtin_bit_cast(float, __builtin_amdgcn_update_dpp(o, __builtin_bit_cast(int, cur), 0x112, 0xf, 0xf, false));
}
struct EpiGeglu {
    static constexpr bool PERM = true, AFTER_DRAIN = false, MID = false;
    bf16_t* act; int ldact; const float* cw; const float* cb; float* head; float* tail; int nch;
    __device__ __forceinline__ void operator()(f32x4 (&acc)[2][2][4][2], const Unit& u, int wr, int wc, int fr, int fq) const {
        const int chb = u.pn * HALF + wc * 32 + 8 * fq;
        if (fr < 2 || fr >= 14) { const bool hd = fr < 2; float* eb = hd ? head : tail; const int er = hd ? fr : fr - 14;
#pragma unroll
            for (int ai = 0; ai < 2; ++ai) { float* ep = eb + ((size_t)(u.pm * 4 + ai * 2 + wr) * 2 + er) * (2 * nch) + u.pn * BM + wc * 32 + 8 * fq;
#pragma unroll
                for (int bj = 0; bj < 2; ++bj)
#pragma unroll
                    for (int n = 0; n < 2; ++n) { const f32x4 v0 = acc[ai][bj][0][n], v3 = acc[ai][bj][3][n]; f32x4 v; v[0] = hd ? v0[0] : v3[0]; v[1] = hd ? v0[1] : v3[1]; v[2] = hd ? v0[2] : v3[2]; v[3] = hd ? v0[3] : v3[3];
                        *(f32x4*)(ep + bj * HALF + 4 * n) = v; } } }
        __builtin_amdgcn_sched_barrier(0);
        f32x4 W[2][4];
        { const int cc = chb; W[0][0] = *(const f32x4*)(cw + cc); W[0][1] = *(const f32x4*)(cw + 2 * nch + cc); W[0][2] = *(const f32x4*)(cw + 4 * nch + cc); W[0][3] = *(const f32x4*)(cb + cc); }
#pragma unroll
        for (int idx = 0; idx < 4; ++idx) { const int n = idx >> 1, bj = idx & 1;
            if (idx < 3) { const int cc = ((idx + 1) & 1) * nch + chb + 4 * ((idx + 1) >> 1);
                W[(idx + 1) & 1][0] = *(const f32x4*)(cw + cc); W[(idx + 1) & 1][1] = *(const f32x4*)(cw + 2 * nch + cc); W[(idx + 1) & 1][2] = *(const f32x4*)(cw + 4 * nch + cc); W[(idx + 1) & 1][3] = *(const f32x4*)(cb + cc); }
            f32x4 w0 = W[idx & 1][0], w1 = W[idx & 1][1], w2 = W[idx & 1][2], bb = W[idx & 1][3];
            asm volatile("" : "+v"(w0), "+v"(w1), "+v"(w2), "+v"(bb));
#pragma unroll
            for (int ai = 0; ai < 2; ++ai) {
#pragma unroll
                for (int m = 3; m >= 0; --m) {
                    const f32x4 cur = acc[ai][bj][m][n], prv = acc[ai][bj][m > 0 ? m - 1 : 0][n]; f32x4 o;
#pragma unroll
                    for (int k = 0; k < 4; ++k) { const float p1 = dpp_prev1(cur[k], prv[k]), p2 = dpp_prev2(cur[k], prv[k]); o[k] = bb[k] + w0[k] * p2 + w1[k] * p1 + w2[k] * cur[k]; }
                    asm volatile("" : "+v"(o));
                    acc[ai][bj][m][n] = o;
                }
            }
            if (bj == 1) {
#pragma unroll
                for (int ai = 0; ai < 2; ++ai)
#pragma unroll
                    for (int m = 0; m < 4; ++m) { const f32x4 g = acc[ai][0][m][n], v = acc[ai][1][m][n]; f32x4 o;
#pragma unroll
                        for (int k = 0; k < 4; ++k) { const float x = g[k]; const float e = __builtin_amdgcn_exp2f(-x * (2.3022082f + 0.10294324f * x * x)); o[k] = x * v[k] * __builtin_amdgcn_rcpf(1.0f + e); }
                        asm volatile("" : "+v"(o));
                        acc[ai][0][m][n] = o; }
            }
        }
        const int row0 = u.pm * BM + wr * 64 + fr;
#pragma unroll
        for (int ai = 0; ai < 2; ++ai)
#pragma unroll
            for (int m = 0; m < 4; ++m) { const f32x4 a = acc[ai][0][m][0], b = acc[ai][0][m][1];
                u32x4 w; w.x = cvt_pk_bf16(a[0], a[1]); w.y = cvt_pk_bf16(a[2], a[3]); w.z = cvt_pk_bf16(b[0], b[1]); w.w = cvt_pk_bf16(b[2], b[3]);
                *(u32x4*)(act + (size_t)(row0 + ai * HALF + m * 16) * ldact + chb) = w; }
    }
};
template <class Epi, class Sched, bool ALIGN_EPI = false, bool SP2 = false>
__device__ __forceinline__ void gemm_phase(PG8_LAS unsigned char* lds, const Gemm g, const Sched& S, const Epi& E, int tid_in) {
    int tid_l = tid_in; asm volatile("" : "+v"(tid_l));
    const int tid = tid_l, wid = __builtin_amdgcn_readfirstlane(tid >> 6), lane = tid & 63, wr = wid >> 2, wc = wid & 3, fr = lane & 15, fq = lane >> 4;
    const int K = g.K, nt = K / BK;
    unsigned voffA[2], voffB[2];
#pragma unroll
    for (int i = 0; i < 2; ++i) { int R, C; stage_rc(tid * 16 + i * 8192, R, C); const int Rb = Epi::PERM ? ((R & ~31) + perm32(R & 31)) : R;
        voffA[i] = (unsigned)(R * g.lda + C) * 2u; voffB[i] = (unsigned)(Rb * K + C) * 2u; }
    const size_t kstep = (size_t)(BK * 2);
    const size_t hstep = (size_t)HALF * K * 2; const size_t hstepA = (size_t)HALF * g.lda * 2; const size_t tstepA = 2 * hstepA;
    const size_t tstep = 2 * hstep;
    const unsigned ldsw = (unsigned)wid * 1024u;
    const int aoff = lds_byte(wr * 64 + fr, fq * 8), boff = lds_byte(wc * 32 + fr, fq * 8);
#define PG8_SA(b, h) (((b) * 2 + (h)) * HTB)
#define PG8_SB(b, h) ((4 + (b) * 2 + (h)) * HTB)
#define PG8_STAGE(bufoff, gbase, voff) do { _Pragma("unroll") for (int _i = 0; _i < 2; ++_i) \
        __builtin_amdgcn_global_load_lds((const unsigned*)((const char*)(gbase) + (voff)[_i]), (PG8_LAS unsigned*)(lds + (bufoff) + ldsw + _i * 8192), 16, 0, 0); } while (0)
#define PG8_LDA(dst, b, h) do { _Pragma("unroll") for (int m = 0; m < 4; ++m) _Pragma("unroll") for (int k = 0; k < 2; ++k) dst[m][k] = *(const PG8_LAS bf16x8*)(lds + PG8_SA(b, h) + aoff + m * 2048 + k * 1024); } while (0)
#define PG8_LDB(dst, b, h) do { _Pragma("unroll") for (int n = 0; n < 2; ++n) _Pragma("unroll") for (int k = 0; k < 2; ++k) dst[n][k] = *(const PG8_LAS bf16x8*)(lds + PG8_SB(b, h) + boff + n * 2048 + k * 1024); } while (0)
#define PG8_MMA(ai, bj, At, Bt) do { __builtin_amdgcn_s_setprio(1); _Pragma("unroll") for (int m = 0; m < 4; ++m) _Pragma("unroll") for (int n = 0; n < 2; ++n) _Pragma("unroll") for (int k = 0; k < 2; ++k) \
        acc[ai][bj][m][n] = __builtin_amdgcn_mfma_f32_16x16x32_bf16(Bt[n][k], At[m][k], acc[ai][bj][m][n], 0, 0, 0); __builtin_amdgcn_s_setprio(0); } while (0)
#define PG8_WAIT_V(n) asm volatile("s_waitcnt vmcnt(" #n ")" ::: "memory")
#define PG8_WAIT_L(n) asm volatile("s_waitcnt lgkmcnt(" #n ")" ::: "memory")
#define PG8_BAR __builtin_amdgcn_s_barrier()
#define PG8_SCHED __builtin_amdgcn_sched_barrier(0)
    Unit cur, nxt; int ui = 0;
    if (!S.next(0, cur)) return;
    f32x4 acc[2][2][4][2];
#pragma unroll
    for (int a = 0; a < 2; ++a)
#pragma unroll
        for (int b = 0; b < 2; ++b)
#pragma unroll
            for (int m = 0; m < 4; ++m)
#pragma unroll
                for (int n = 0; n < 2; ++n) acc[a][b][m][n] = (f32x4){0.f, 0.f, 0.f, 0.f};
    bf16x8 At[4][2], B0[2][2], B1[2][2];
    const char* cA = (const char*)g.A + (size_t)cur.pm * tstepA + (size_t)(cur.pn & 1) * g.aalt; const char* cB = (const char*)g.Bt + (size_t)cur.pn * tstep;
    S.a_ready(cur);
    if constexpr (SP2) {
        PG8_STAGE(PG8_SB(0, 0), cB, voffB); PG8_STAGE(PG8_SB(0, 1), cB + hstep, voffB); PG8_STAGE(PG8_SA(0, 0), cA, voffA); PG8_STAGE(PG8_SA(0, 1), cA + hstepA, voffA);
        if (wr == 1) PG8_BAR;
        PG8_WAIT_V(2); PG8_BAR;
        PG8_STAGE(PG8_SB(1, 0), cB + kstep, voffB); PG8_STAGE(PG8_SA(1, 0), cA + kstep, voffA); PG8_STAGE(PG8_SB(1, 1), cB + hstep + kstep, voffB);
        PG8_WAIT_V(6); PG8_BAR;
    } else {
        PG8_STAGE(PG8_SB(0, 0), cB, voffB); PG8_STAGE(PG8_SA(0, 0), cA, voffA); PG8_STAGE(PG8_SB(0, 1), cB + hstep, voffB); PG8_STAGE(PG8_SA(0, 1), cA + hstepA, voffA);
        if (wr == 1) PG8_BAR;
        PG8_WAIT_V(4); PG8_BAR;
        PG8_STAGE(PG8_SB(1, 0), cB + kstep, voffB); PG8_STAGE(PG8_SA(1, 0), cA + kstep, voffA); PG8_STAGE(PG8_SB(1, 1), cB + hstep + kstep, voffB);
        PG8_WAIT_V(6); PG8_BAR;
    }
    for (;;) {
        const bool has_next = S.next(ui + 1, nxt);
        const char* nA = has_next ? (const char*)g.A + (size_t)nxt.pm * tstepA + (size_t)(nxt.pn & 1) * g.aalt : cA; const char* nB = has_next ? (const char*)g.Bt + (size_t)nxt.pn * tstep : cB;
        for (int t = 0; t < nt; t += 2) {
            const bool last = (t == nt - 2);
            const char* a1 = cA + (size_t)(t + 1) * kstep;
            const char* a2 = last ? nA : cA + (size_t)(t + 2) * kstep; const char* b2 = last ? nB : cB + (size_t)(t + 2) * kstep;
            const char* a3 = a2 + kstep; const char* b3 = b2 + kstep;
            if (last && has_next) S.a_ready(nxt);
            if constexpr (SP2) {
            PG8_LDB(B0, 0, 0); PG8_LDB(B1, 0, 1); PG8_SCHED; PG8_LDA(At, 0, 0); PG8_STAGE(PG8_SA(1, 1), a1 + hstepA, voffA);
            PG8_WAIT_V(8); PG8_WAIT_L(0); PG8_BAR; PG8_MMA(0, 0, At, B0); PG8_MMA(0, 1, At, B1); PG8_BAR; PG8_SCHED;
            PG8_LDA(At, 0, 1); PG8_STAGE(PG8_SB(0, 0), b2, voffB); PG8_STAGE(PG8_SB(0, 1), b2 + hstep, voffB); PG8_STAGE(PG8_SA(0, 0), a2, voffA);
            PG8_WAIT_V(8); PG8_WAIT_L(0); PG8_BAR; PG8_MMA(1, 0, At, B0); PG8_MMA(1, 1, At, B1); PG8_BAR; PG8_SCHED;
            PG8_LDB(B0, 1, 0); PG8_LDB(B1, 1, 1); PG8_SCHED; PG8_LDA(At, 1, 0); PG8_STAGE(PG8_SA(0, 1), a2 + hstepA, voffA);
            PG8_WAIT_V(8); PG8_WAIT_L(0); PG8_BAR; PG8_MMA(0, 0, At, B0); PG8_MMA(0, 1, At, B1); PG8_BAR; PG8_SCHED;
            PG8_LDA(At, 1, 1); PG8_STAGE(PG8_SB(1, 0), b3, voffB); PG8_STAGE(PG8_SB(1, 1), b3 + hstep, voffB); PG8_STAGE(PG8_SA(1, 0), a3, voffA);
            PG8_WAIT_V(8); PG8_WAIT_L(0); PG8_BAR; PG8_MMA(1, 0, At, B0); PG8_MMA(1, 1, At, B1); PG8_BAR; PG8_SCHED;
            } else {
            PG8_LDB(B0, 0, 0); PG8_SCHED; PG8_LDA(At, 0, 0); PG8_STAGE(PG8_SA(1, 1), a1 + hstepA, voffA);
            PG8_WAIT_L(8); PG8_BAR; PG8_WAIT_L(0); PG8_MMA(0, 0, At, B0); PG8_BAR; PG8_SCHED;
            PG8_LDB(B1, 0, 1); PG8_STAGE(PG8_SB(0, 0), b2, voffB);
            PG8_BAR; PG8_WAIT_L(0); PG8_MMA(0, 1, At, B1); PG8_BAR;
            PG8_LDA(At, 0, 1); PG8_STAGE(PG8_SA(0, 0), a2, voffA);
            PG8_BAR; PG8_WAIT_L(0); PG8_MMA(1, 0, At, B0); PG8_BAR; PG8_SCHED;
            PG8_STAGE(PG8_SB(0, 1), b2 + hstep, voffB);
            PG8_WAIT_V(6); PG8_BAR; PG8_MMA(1, 1, At, B1); PG8_BAR;
            PG8_LDB(B0, 1, 0); PG8_SCHED; PG8_LDA(At, 1, 0); PG8_STAGE(PG8_SA(0, 1), a2 + hstepA, voffA);
            PG8_WAIT_L(8); PG8_BAR; PG8_WAIT_L(0); PG8_MMA(0, 0, At, B0); PG8_BAR; PG8_SCHED;
            PG8_LDB(B1, 1, 1); PG8_STAGE(PG8_SB(1, 0), b3, voffB);
            PG8_BAR; PG8_WAIT_L(0); PG8_MMA(0, 1, At, B1); PG8_BAR;
            PG8_LDA(At, 1, 1); PG8_STAGE(PG8_SA(1, 0), a3, voffA);
            PG8_BAR; PG8_WAIT_L(0); PG8_MMA(1, 0, At, B0); PG8_BAR; PG8_SCHED;
            PG8_STAGE(PG8_SB(1, 1), b3 + hstep, voffB);
            PG8_WAIT_V(6); PG8_BAR; PG8_MMA(1, 1, At, B1); PG8_BAR;
            }
        }
        if constexpr (ALIGN_EPI) { if (wr == 0) PG8_BAR; }
        if constexpr (!Epi::AFTER_DRAIN) { E(acc, cur, wr, wc, fr, fq); S.done(cur); }
        if (!has_next) break;
#pragma unroll
        for (int a = 0; a < 2; ++a)
#pragma unroll
            for (int b = 0; b < 2; ++b)
#pragma unroll
                for (int m = 0; m < 4; ++m)
#pragma unroll
                    for (int n = 0; n < 2; ++n) acc[a][b][m][n] = (f32x4){0.f, 0.f, 0.f, 0.f};
        cur = nxt; cA = nA; cB = nB; ++ui;
        if constexpr (ALIGN_EPI) { if (wr == 1) PG8_BAR; }
    }
    PG8_WAIT_V(0);
    if constexpr (!ALIGN_EPI) { if (wr == 0) PG8_BAR; }
    PG8_BAR;
    if constexpr (Epi::AFTER_DRAIN) { E.fused(acc, cur, wr, wc, fr, fq, lds, wid, lane); S.done(cur); }
#undef PG8_SA
#undef PG8_SB
#undef PG8_STAGE
#undef PG8_LDA
#undef PG8_LDB
#undef PG8_MMA
#undef PG8_WAIT_V
#undef PG8_WAIT_L
#undef PG8_BAR
#undef PG8_SCHED
}
}
#define LAS __attribute__((address_space(3)))
typedef unsigned short bf16;
typedef unsigned v4u __attribute__((ext_vector_type(4)));
typedef unsigned v2u __attribute__((ext_vector_type(2)));
typedef float f32x4 __attribute__((ext_vector_type(4)));
typedef float f32x16 __attribute__((ext_vector_type(16)));
typedef short bf16x8 __attribute__((ext_vector_type(8)));
typedef short v4i16_t __attribute__((ext_vector_type(4)));
constexpr int NB = 8, S_ = 2048, D_ = 2048, T_ = NB * S_;
constexpr int NP = 11776;
constexpr int NIN = 11600;
constexpr int C_LX = 0, C_LG = 2048, C_Q = 4096, C_K = 6144, C_V = 6272, C_QI = 6400, C_KI = 7424, C_WI = 7488, C_GL = 7680, C_GA = 9728;
constexpr int FF = 6144, FF2 = 12288;
constexpr float LN_EPS = 1e-5f;
constexpr float ALPHA = 1.189207115f;
constexpr size_t MiB = 1u << 20;
constexpr size_t WS_WINT = 0, WS_XB = 48 * MiB;
constexpr size_t WS_WLA = 0, WS_WOUT = 16 * MiB, WS_WUP = 24 * MiB, WS_WDN = 72 * MiB;
constexpr size_t WS_PROJ = 112 * MiB;
constexpr size_t WS_KIN = 480 * MiB;
constexpr size_t WS_H1B = 112 * MiB, WS_ACT = 176 * MiB, WS_HEAD = 368 * MiB, WS_TAIL = 400 * MiB;
constexpr size_t WS_CTL = 482 * MiB;
constexpr size_t WS_END = 483 * MiB;
constexpr int LDS_BYTES = 147456;

__device__ __forceinline__ float bf_lo(unsigned u) { return __uint_as_float(u << 16); }
__device__ __forceinline__ float bf_hi(unsigned u) { return __uint_as_float(u & 0xffff0000u); }
__device__ __forceinline__ float bf1(bf16 h) { return __uint_as_float(((unsigned)h) << 16); }
__device__ __forceinline__ unsigned f2bf(float f) { unsigned u = __float_as_uint(f); return (u + 0x7fffu + ((u >> 16) & 1u)) >> 16; }
__device__ __forceinline__ unsigned pk2(float lo, float hi) { return pg8::cvt_pk_bf16(lo, hi); }
__device__ __forceinline__ float sigmoidf_(float x) { return __builtin_amdgcn_rcpf(1.0f + __expf(-x)); }
__device__ __forceinline__ float gelu_t(float x) { const float e = __builtin_amdgcn_exp2f(-x * (2.3022082f + 0.10294324f * x * x)); return x * __builtin_amdgcn_rcpf(1.0f + e); }
__device__ __forceinline__ float wave_sum(float v) {
#pragma unroll
    for (int o = 1; o < 64; o <<= 1) v += __shfl_xor(v, o);
    return v;
}
#define XB_TMO      128
#define XB_XCNT(j)  (256  + 64 * (j))
#define XB_XSUB(j)  (1280 + 64 * (j))
#define XB_XGEN(j)  (2304 + 64 * (j))
#define XB_TOP      3328
#define XB_TOPGEN   3392
#define XCD_BAR_WORDS 3456
#define XB_SPIN_CAP (1u << 18)

__device__ __forceinline__ unsigned xb_ld(unsigned* p)              { return __hip_atomic_load(p, __ATOMIC_RELAXED, __HIP_MEMORY_SCOPE_AGENT); }
__device__ __forceinline__ unsigned xb_add(unsigned* p, unsigned v) { return __hip_atomic_fetch_add(p, v, __ATOMIC_RELAXED, __HIP_MEMORY_SCOPE_AGENT); }
__device__ __forceinline__ unsigned xb_xcc_id() { return (unsigned)__builtin_amdgcn_s_getreg((3 << 11) | 20) & 0xFu; }
#define XB_SPIN(cond, bar) do { unsigned _sp = 0; while (cond) { __builtin_amdgcn_s_sleep(1); \
    if ((++_sp & 255u) == 0u) { if (xb_ld(&(bar)[XB_TMO])) break; if (_sp > XB_SPIN_CAP) { atomicAdd(&(bar)[XB_TMO], 1u); break; } } } } while (0)

struct XcdBarrier {
    unsigned* bar; unsigned x;
    volatile LAS unsigned* st;
};

__device__ __forceinline__ XcdBarrier xcd_barrier_post(unsigned* bar, volatile LAS unsigned* st, int tid) {
    XcdBarrier b; b.bar = bar; b.x = xb_xcc_id(); b.st = st;
    if (tid == 0) (void)xb_add(&bar[XB_XCNT(b.x)], 1u);
    return b;
}
__device__ __forceinline__ void xcd_barrier_complete(unsigned* bar, unsigned x, unsigned& nloc, unsigned& nx) {
    const unsigned G = gridDim.x * gridDim.y * gridDim.z;
    unsigned sum, cnt, mine, sp = 0u;
    for (;;) {
        sum = 0u; cnt = 0u; mine = 0u;
#pragma unroll
        for (unsigned j = 0; j < 16; ++j) { const unsigned c = xb_ld(&bar[XB_XCNT(j)]); sum += c; cnt += (c > 0u) ? 1u : 0u; mine = (j == x) ? c : mine; }
        if (sum == G) break;
        __builtin_amdgcn_s_sleep(1);
        if ((++sp & 255u) == 0u) { if (xb_ld(&bar[XB_TMO])) break; if (sp > XB_SPIN_CAP) { atomicAdd(&bar[XB_TMO], 1u); break; } }
    }
    nloc = mine > 0u ? mine : 1u; nx = cnt > 0u ? cnt : 1u;
}

__device__ __forceinline__ void xcd_barrier(const XcdBarrier& b, int tid) {
    asm volatile("s_waitcnt vmcnt(0)" ::: "memory");
    __syncthreads();
    if (tid == 0) {
        unsigned* bar = b.bar;
        __builtin_amdgcn_s_waitcnt(0);
        unsigned nloc = b.st[0], nx = b.st[1];
        if (nloc == 0u) { xcd_barrier_complete(bar, b.x, nloc, nx); b.st[0] = nloc; b.st[1] = nx; }
        const unsigned old = xb_add(&bar[XB_XSUB(b.x)], 1u);
        const unsigned gen = old / nloc;
        if (old + 1u == (gen + 1u) * nloc) {
            __builtin_amdgcn_fence(__ATOMIC_RELEASE, "agent");
            asm volatile("s_waitcnt vmcnt(0)" ::: "memory");
            const unsigned og = xb_add(&bar[XB_TOP], 1u);
            const unsigned tg = og / nx;
            if (og + 1u == (tg + 1u) * nx) xb_add(&bar[XB_TOPGEN], 1u);
            else XB_SPIN(xb_ld(&bar[XB_TOPGEN]) == tg, bar);
            __builtin_amdgcn_fence(__ATOMIC_ACQUIRE, "agent");
            xb_add(&bar[XB_XGEN(b.x)], 1u);
            asm volatile("s_waitcnt vmcnt(0)" ::: "memory");
        } else {
            XB_SPIN(xb_ld(&bar[XB_XGEN(b.x)]) == gen, bar);
            __builtin_amdgcn_fence(__ATOMIC_ACQUIRE, "agent");
            asm volatile("s_waitcnt vmcnt(0)" ::: "memory");
        }
    }
    __syncthreads();
}
struct P {
    const float *x, *w_in, *lru_conv_w, *lru_conv_b, *ga_w, *ga_b, *gx_w, *gx_b, *lam, *kn_g, *kn_b, *rel_bias, *w_pl, *w_pa, *w_out, *ln1_g, *ln1_b, *w_up, *fc_w, *fc_b, *w_dn, *ln2_g, *ln2_b;
    float* out; unsigned char* ws;
};
template <class MapN>
__device__ __forceinline__ void transpose_item(const float* W, int N, bf16* WT, int ldk, int koff, LAS float* scr, int kb, int nb, int lane, MapN map) {
    const int k0 = 64 * kb, n0 = 32 * nb; const int nn = n0 + (lane & 31);
#pragma unroll 8
    for (int i = 0; i < 32; ++i) { const int kk = 2 * i + (lane >> 5); scr[kk * 33 + (lane & 31)] = nn < N ? W[(size_t)(k0 + kk) * N + nn] : 0.f; }
    asm volatile("s_waitcnt lgkmcnt(0)" ::: "memory");
    const int c = lane & 7;
#pragma unroll
    for (int j = 0; j < 4; ++j) { const int n = (lane >> 3) + 8 * j; const LAS float* s = scr + (8 * c) * 33 + n;
        v4u o; o.x = pk2(s[0 * 33], s[1 * 33]); o.y = pk2(s[2 * 33], s[3 * 33]); o.z = pk2(s[4 * 33], s[5 * 33]); o.w = pk2(s[6 * 33], s[7 * 33]);
        if (n0 + n < N) *(v4u*)(WT + (size_t)map(n0 + n) * ldk + koff + k0 + 8 * c) = o; }
    asm volatile("s_waitcnt lgkmcnt(0)" ::: "memory");
}
struct MapId { __device__ __forceinline__ int operator()(int n) const { return n; } };
struct MapPair { int sel; __device__ __forceinline__ int operator()(int n) const { return 512 * (n >> 8) + 256 * sel + (n & 255); } };
struct MapIn { __device__ __forceinline__ int operator()(int n) const { return n < 7504 ? n : n + 176; } };
struct MapUp { __device__ __forceinline__ int operator()(int n) const { const int v = n >= FF ? 1 : 0, j = n - v * FF; return 256 * (j >> 7) + 128 * v + (j & 127); } };

__device__ __forceinline__ void phase0(const P& p, LAS unsigned char* lds, int gw, int NGW, int lane, int wave) {
    LAS float* scr = (LAS float*)(lds + wave * 16384);
    bf16* winT = (bf16*)(p.ws + WS_WINT);
    constexpr int NBLK = (NIN + 31) / 32;
    for (int it = gw; it < 32 * NBLK; it += NGW) transpose_item(p.w_in, NIN, winT, D_, 0, scr, it / NBLK, it % NBLK, lane, MapIn());
    for (int i = gw * 64 + lane; i < 176 * D_ / 8; i += NGW * 64) *(v4u*)(winT + (size_t)7504 * D_ + (size_t)i * 8) = (v4u){0u, 0u, 0u, 0u};
    bf16* xb = (bf16*)(p.ws + WS_XB);
    for (size_t i = (size_t)gw * 64 + lane; i < (size_t)T_ * D_ / 8; i += (size_t)NGW * 64) {
        const f32x4 a = *(const f32x4*)(p.x + i * 8), b = *(const f32x4*)(p.x + i * 8 + 4);
        v4u o; o.x = pk2(a[0], a[1]); o.y = pk2(a[2], a[3]); o.z = pk2(b[0], b[1]); o.w = pk2(b[2], b[3]);
        *(v4u*)(xb + i * 8) = o; }
}
__device__ __forceinline__ void phase15(const P& p, LAS unsigned char* lds, int gw, int NGW, int lane, int wave) {
    LAS float* scr = (LAS float*)(lds + wave * 16384);
    bf16* wla = (bf16*)(p.ws + WS_WLA); bf16* wout = (bf16*)(p.ws + WS_WOUT); bf16* wup = (bf16*)(p.ws + WS_WUP); bf16* wdn = (bf16*)(p.ws + WS_WDN);
    constexpr int I_SQ = 32 * 64, I_UP = 32 * (FF2 / 32), I_DN = (FF / 64) * 64;
    constexpr int NIT = 3 * I_SQ + I_UP + I_DN;
    for (int it = gw; it < NIT; it += NGW) {
        int r = it;
        if (r < I_SQ) { transpose_item(p.w_pl, D_, wla, D_, 0, scr, r / 64, r % 64, lane, MapPair{0}); continue; } r -= I_SQ;
        if (r < I_SQ) { transpose_item(p.w_pa, D_, wla, D_, 0, scr, r / 64, r % 64, lane, MapPair{1}); continue; } r -= I_SQ;
        if (r < I_SQ) { transpose_item(p.w_out, D_, wout, D_, 0, scr, r / 64, r % 64, lane, MapId()); continue; } r -= I_SQ;
        if (r < I_UP) { transpose_item(p.w_up, FF2, wup, D_, 0, scr, r / (FF2 / 32), r % (FF2 / 32), lane, MapUp()); continue; } r -= I_UP;
        transpose_item(p.w_dn, D_, wdn, FF, 0, scr, r / 64, r % 64, lane, MapId());
    }
    const bf16* proj = (const bf16*)(p.ws + WS_PROJ); bf16* kin = (bf16*)(p.ws + WS_KIN);
    const float g = p.kn_g[lane], bta = p.kn_b[lane];
    for (int t = gw; t < T_; t += NGW) {
        const float v = bf1(proj[(size_t)t * NP + C_KI + lane]);
        const float mu = wave_sum(v) * (1.f / 64.f); const float d = v - mu; const float var = wave_sum(d * d) * (1.f / 64.f);
        kin[(size_t)t * 64 + lane] = (bf16)f2bf(d * __builtin_amdgcn_rsqf(var + LN_EPS) * g + bta);
    }
}
__device__ __forceinline__ void ln_rows(float* io, bf16* ob, const float* gam, const float* bet, int gw, int NGW, int lane) {
    for (int t = gw; t < T_; t += NGW) {
        f32x4* r = (f32x4*)(io + (size_t)t * D_) + lane; f32x4 v[8]; float s = 0.f;
#pragma unroll
        for (int j = 0; j < 8; ++j) { v[j] = r[64 * j]; s += (v[j][0] + v[j][1]) + (v[j][2] + v[j][3]); }
        const float mu = wave_sum(s) * (1.f / D_); float q = 0.f;
#pragma unroll
        for (int j = 0; j < 8; ++j) { v[j] = v[j] - mu; q += (v[j][0] * v[j][0] + v[j][1] * v[j][1]) + (v[j][2] * v[j][2] + v[j][3] * v[j][3]); }
        const float rstd = 1.0f / sqrtf(wave_sum(q) * (1.f / D_) + LN_EPS);
#pragma unroll
        for (int j = 0; j < 8; ++j) { const f32x4 g = *((const f32x4*)gam + lane + 64 * j), b = *((const f32x4*)bet + lane + 64 * j); const f32x4 o = v[j] * rstd * g + b; r[64 * j] = o;
            if (ob) { v2u w; w.x = pk2(o[0], o[1]); w.y = pk2(o[2], o[3]); *(v2u*)(ob + (size_t)t * D_ + 4 * (lane + 64 * j)) = w; } }
    }
}
__device__ __forceinline__ void ffn_fixup(const P& p, int gtid, int NT) {
    const float* head = (const float*)(p.ws + WS_HEAD); const float* tail = (const float*)(p.ws + WS_TAIL); bf16* act = (bf16*)(p.ws + WS_ACT);
    for (int i = gtid; i < (T_ / 64) * 2 * FF; i += NT) {
        const int j = i % FF, gr = i / FF, r = gr & 1, G = gr >> 1; const int tc = 256 * (j >> 7) + (j & 127);
        const bool first = (G & 31) == 0;
        float o2[2];
#pragma unroll
        for (int v = 0; v < 2; ++v) { const int c = tc + 128 * v, ch = j + v * FF;
            const float h0 = head[((size_t)G * 2 + 0) * FF2 + c], h1 = head[((size_t)G * 2 + 1) * FF2 + c];
            const float t0 = first ? 0.f : tail[((size_t)(G - 1) * 2 + 0) * FF2 + c], t1 = first ? 0.f : tail[((size_t)(G - 1) * 2 + 1) * FF2 + c];
            const float x0 = r ? h1 : h0, x1 = r ? h0 : t1, x2 = r ? t1 : t0;
            o2[v] = p.fc_b[ch] + p.fc_w[ch] * x2 + p.fc_w[FF2 + ch] * x1 + p.fc_w[2 * FF2 + ch] * x0; }
        act[(size_t)(G * 64 + r) * FF + j] = (bf16)f2bf(gelu_t(o2[0]) * o2[1]);
    }
}
template <bool STORE>
__device__ __forceinline__ void lru_unit(const P& p, LAS unsigned char* lds, int u, int tid, int lane, int wave) {
    constexpr int XA_P = 272;
    constexpr int GT_P = 132;
    LAS unsigned char* XA = lds;
    LAS float* XC = (LAS float*)(lds + 34816);
    LAS float* GT = (LAS float*)(lds + 67584);
    LAS float* SEGA = (LAS float*)(lds + 135168);
    LAS float* SEGH = SEGA + 512;
    LAS float* CAR = SEGH + 512;
    const int b = u >> 5, n = (u & 31) >> 1, half = u & 1, cin0 = 128 * n, cout0 = cin0 + 64 * half;
    bf16* proj = (bf16*)(p.ws + WS_PROJ);
    const int fr = lane & 15, fq = lane >> 4;
    bf16x8 Bf[4];
    { const float* Wg = (wave < 4 ? p.ga_w : p.gx_w) + (size_t)n * 128 * 128 + 64 * half + 16 * (wave & 3) + fr;
#pragma unroll
      for (int s = 0; s < 4; ++s) { unsigned w[4];
#pragma unroll
          for (int jj = 0; jj < 4; ++jj) w[jj] = pk2(Wg[(size_t)(32 * s + 8 * fq + 2 * jj) * 128], Wg[(size_t)(32 * s + 8 * fq + 2 * jj + 1) * 128]);
          Bf[s] = __builtin_bit_cast(bf16x8, (v4u){w[0], w[1], w[2], w[3]}); } }
    const int c = tid & 63, seg = tid >> 6;
    const float ba = p.ga_b[cout0 + c], bx = p.gx_b[cout0 + c];
    const float sp8 = -8.0f * log1pf(__expf(-p.lam[cout0 + c]));
    if (tid < 128) CAR[tid] = 0.f;
    const int cg8 = tid & 15, tg = tid >> 4;
    for (int ch = 0; ch < S_ / 128; ++ch) {
        const int tc0 = ch * 128;
        {
            float wj[4][8], bb[8];
#pragma unroll
            for (int j = 0; j < 4; ++j) { const f32x4 a = *(const f32x4*)(p.lru_conv_w + j * D_ + cin0 + 8 * cg8), d = *(const f32x4*)(p.lru_conv_w + j * D_ + cin0 + 8 * cg8 + 4);
#pragma unroll
                for (int e = 0; e < 4; ++e) { wj[j][e] = a[e]; wj[j][4 + e] = d[e]; } }
            { const f32x4 a = *(const f32x4*)(p.lru_conv_b + cin0 + 8 * cg8), d = *(const f32x4*)(p.lru_conv_b + cin0 + 8 * cg8 + 4);
#pragma unroll
              for (int e = 0; e < 4; ++e) { bb[e] = a[e]; bb[4 + e] = d[e]; } }
            float xr[7][8];
#pragma unroll
            for (int r = 0; r < 7; ++r) { const int t = tc0 + 4 * tg - 3 + r;
                v4u raw = (v4u){0u, 0u, 0u, 0u};
                if (t >= 0) raw = *(const v4u*)(proj + (size_t)(b * S_ + t) * NP + C_LX + cin0 + 8 * cg8);
#pragma unroll
                for (int k = 0; k < 4; ++k) { xr[r][2 * k] = bf_lo(raw[k]); xr[r][2 * k + 1] = bf_hi(raw[k]); } }
#pragma unroll
            for (int q = 0; q < 4; ++q) { float o[8];
#pragma unroll
                for (int e = 0; e < 8; ++e) o[e] = bb[e] + wj[0][e] * xr[q][e] + wj[1][e] * xr[q + 1][e] + wj[2][e] * xr[q + 2][e] + wj[3][e] * xr[q + 3][e];
                const int tok = 4 * tg + q;
                v4u w; w.x = pk2(o[0], o[1]); w.y = pk2(o[2], o[3]); w.z = pk2(o[4], o[5]); w.w = pk2(o[6], o[7]);
                *(LAS v4u*)(XA + tok * XA_P + cg8 * 16) = w;
                if ((cg8 >> 3) == half) { LAS float* xc = XC + tok * 64 + 8 * (cg8 & 7); *(LAS f32x4*)xc = (f32x4){o[0], o[1], o[2], o[3]}; *(LAS f32x4*)(xc + 4) = (f32x4){o[4], o[5], o[6], o[7]}; } }
        }
        bf16 lg[16];
#pragma unroll
        for (int k = 0; k < 16; ++k) lg[k] = proj[(size_t)(b * S_ + tc0 + 16 * seg + k) * NP + C_LG + cout0 + c];
        __syncthreads();
#pragma unroll
        for (int rt = 0; rt < 8; ++rt) { f32x4 acc = (f32x4){0.f, 0.f, 0.f, 0.f};
#pragma unroll
            for (int s = 0; s < 4; ++s) { const bf16x8 a = *(const LAS bf16x8*)(XA + (16 * rt + fr) * XA_P + (32 * s + 8 * fq) * 2); acc = __builtin_amdgcn_mfma_f32_16x16x32_bf16(a, Bf[s], acc, 0, 0, 0); }
#pragma unroll
            for (int i = 0; i < 4; ++i) GT[(16 * rt + 4 * fq + i) * GT_P + 16 * wave + fr] = acc[i]; }
        __syncthreads();
        float av[16], uv[16]; float hl = 0.f, Al = 1.f;
#pragma unroll
        for (int k = 0; k < 16; ++k) { const int tok = 16 * seg + k;
            const float r = sigmoidf_(GT[tok * GT_P + c] + ba), ii = sigmoidf_(GT[tok * GT_P + 64 + c] + bx);
            const float a = __expf(sp8 * r); float mult = sqrtf(fmaxf(1.0f - a * a, 0.f)); if (tc0 + tok == 0) mult = 1.0f;
            const float uu = mult * ii * XC[tok * 64 + c];
            av[k] = a; uv[k] = uu; hl = a * hl + uu; Al *= a; }
        SEGA[seg * 64 + c] = Al; SEGH[seg * 64 + c] = hl;
        __syncthreads();
        float cin = CAR[(ch & 1) * 64 + c];
        for (int s2 = 0; s2 < seg; ++s2) cin = SEGA[s2 * 64 + c] * cin + SEGH[s2 * 64 + c];
        if (seg == 7) CAR[((ch + 1) & 1) * 64 + c] = Al * cin + hl;
        float h = cin;
#pragma unroll
        for (int k = 0; k < 16; ++k) { h = av[k] * h + uv[k];
            const bf16 yv = (bf16)f2bf(gelu_t(bf1(lg[k])) * h); if (STORE || yv == 0x1234) proj[(size_t)(b * S_ + tc0 + 16 * seg + k) * NP + C_LG + cout0 + c] = yv; }
    }
    __syncthreads();
}
constexpr int A_VT = 0, VT_P = 288, A_LIST = 73728, A_BUCK = 81920, A_BIAS = 83968;
__device__ __forceinline__ unsigned offb(unsigned row, unsigned ch) { return 256u * row + 16u * (ch ^ (((row & 3) << 2) | ((row >> 2) & 3))); }
__device__ __forceinline__ void dsa_tables(const P& p, LAS unsigned char* lds, int tid) {
    LAS unsigned char* BUCK = lds + A_BUCK; LAS float* BIAS = (LAS float*)(lds + A_BIAS);
    for (int rel = tid; rel < S_; rel += 512) { int bk;
        if (rel < 16) bk = rel; else { const float nf = (float)rel; int lg = 16 + (int)(logf(nf / 16.0f) / 2.0794415416798357f * 16.0f); bk = lg < 31 ? lg : 31; }
        BUCK[rel] = (unsigned char)bk; }
    BIAS[tid] = p.rel_bias[tid];
    __syncthreads();
}
template <bool STORE>
__device__ __forceinline__ void dsa_unit(const P& p, LAS unsigned char* lds, int b, int tg, int lane, int wave) {
    bf16* proj = (bf16*)(p.ws + WS_PROJ); const bf16* kin = (const bf16*)(p.ws + WS_KIN);
    LAS unsigned short* LIST = (LAS unsigned short*)(lds + A_LIST) + wave * 512;
    LAS unsigned char* VT = lds + A_VT + wave * (32 * VT_P);
    const LAS unsigned char* BUCK = lds + A_BUCK; const LAS float* BIAS = (const LAS float*)(lds + A_BIAS);
    const int t0 = 16 * tg + 2 * wave;
    const size_t rowb = (size_t)b * S_;
    unsigned scr[64];
#ifdef DSA_NOIDX
#pragma unroll
    for (int j = 0; j < 64; ++j) scr[j] = lane * j;
#else
    {
        const int r = lane & 31, kh = lane >> 5;
        const int atok = t0 + ((r >> 2) & 1), ahead = 4 * (r >> 3) + (r & 3);
        bf16x8 Aq[4];
        { const bf16* qp = proj + (rowb + atok) * NP + C_QI + ahead * 64 + 32 * kh;
#pragma unroll
          for (int s = 0; s < 4; ++s) Aq[s] = *(const bf16x8*)(qp + 8 * s); }
        float wv[16];
        { const bf16* wp = proj + (rowb + t0 + kh) * NP + C_WI; const v4u w0 = *(const v4u*)wp, w1 = *(const v4u*)(wp + 8);
#pragma unroll
          for (int k = 0; k < 4; ++k) { wv[2 * k] = bf_lo(w0[k]) * 0.03125f; wv[2 * k + 1] = bf_hi(w0[k]) * 0.03125f; wv[8 + 2 * k] = bf_lo(w1[k]) * 0.03125f; wv[9 + 2 * k] = bf_hi(w1[k]) * 0.03125f; } }
        const int mytok = t0 + kh;
        const int ngrp = (t0 + 1) / 256 + 1;
#pragma unroll
        for (int g8 = 0; g8 < 8; ++g8) {
            if (g8 < ngrp) {
                bf16x8 kb[2][4];
                int l2 = lane; asm volatile("" : "+v"(l2));
                const bf16* kp = kin + (rowb + 32 * (g8 * 8) + (l2 & 31)) * 64 + 32 * (l2 >> 5);
                asm volatile("" : "+v"(kp));
#pragma unroll
                for (int s = 0; s < 4; ++s) kb[0][s] = *(const bf16x8*)(kp + 8 * s);
#pragma unroll
                for (int j = 0; j < 8; ++j) { const int blk = g8 * 8 + j, key = 32 * blk + r;
                    if (j < 7) { kp += 32 * 64; asm volatile("" : "+v"(kp));
#pragma unroll
                        for (int s = 0; s < 4; ++s) kb[(j + 1) & 1][s] = *(const bf16x8*)(kp + 8 * s); }
                    f32x16 acc;
#pragma unroll
                    for (int e = 0; e < 16; ++e) acc[e] = 0.f;
#pragma unroll
                    for (int s = 0; s < 4; ++s) acc = __builtin_amdgcn_mfma_f32_32x32x16_bf16(Aq[s], kb[j & 1][s], acc, 0, 0, 0);
                    float sc = 0.f;
#pragma unroll
                    for (int e = 0; e < 16; ++e) sc += wv[e] * fmaxf(acc[e], 0.f);
                    const unsigned ub = __float_as_uint(sc); const unsigned mono = ub ^ ((ub >> 31) ? 0xFFFFFFFFu : 0x80000000u);
                    unsigned sv = key <= mytok ? mono : 0u; asm volatile("" : "+v"(sv)); scr[blk] = sv;
                    __builtin_amdgcn_sched_barrier(0); }
            } else {
#pragma unroll
                for (int j = 0; j < 8; ++j) scr[g8 * 8 + j] = 0u;
            }
        }
    }
#endif
    {
        unsigned T = 0u;
        for (int bit = 31; bit >= 0; --bit) {
            const unsigned cand = T | (1u << bit); int clo = 0, chi = 0;
#pragma unroll
            for (int j = 0; j < 64; ++j) { const unsigned long long m = __ballot(scr[j] >= cand); clo += __popc((unsigned)m); chi += __popc((unsigned)(m >> 32)); }
            if ((lane < 32 ? clo : chi) >= 256) T = cand;
        }
        const unsigned Tm = T > 1u ? T : 1u;
        LAS unsigned short* mylist = LIST + (lane >> 5) * 256; int blo = 0, bhi = 0;
#pragma unroll
        for (int j = 0; j < 64; ++j) { const bool s = scr[j] >= Tm; const unsigned long long m = __ballot(s); const unsigned mlo = (unsigned)m, mhi = (unsigned)(m >> 32);
            const unsigned mm = lane < 32 ? mlo : mhi; const int pos = (lane < 32 ? blo : bhi) + __popc(mm & ((1u << (lane & 31)) - 1u));
            if (s && pos < 256) mylist[pos] = (unsigned short)(32 * j + (lane & 31));
            blo += __popc(mlo); bhi += __popc(mhi); }
        for (int q = (lane < 32 ? blo : bhi) + (lane & 31); q < 256; q += 32) mylist[q] = 0xFFFFu;
    }
    asm volatile("s_waitcnt lgkmcnt(0)" ::: "memory");
#ifndef DSA_NOATT
    int lane_a = lane; asm volatile("" : "+v"(lane_a));
    const int fr = lane_a & 15, fq = lane_a >> 4;
#pragma unroll 1
    for (int tt = 0; tt < 2; ++tt) {
        const int tok = t0 + tt; const LAS unsigned short* list = LIST + tt * 256;
        bf16x8 Qf[4];
        { const bf16* qp = proj + (rowb + tok) * NP + C_Q + fr * 128 + 32 * fq;
#pragma unroll
          for (int s = 0; s < 4; ++s) Qf[s] = *(const bf16x8*)(qp + 8 * s); }
        f32x4 sr[16];
#pragma unroll
        for (int gq = 0; gq < 4; ++gq) {
            bf16x8 kf[4][4];
#pragma unroll
            for (int g4 = 0; g4 < 4; ++g4) { const unsigned id = list[16 * (4 * gq + g4) + fr]; const unsigned key = id == 0xFFFFu ? 0u : id;
                const bf16* kp = proj + (rowb + key) * NP + C_K + 32 * fq;
#pragma unroll
                for (int s = 0; s < 4; ++s) kf[g4][s] = *(const bf16x8*)(kp + 8 * s); }
#pragma unroll
            for (int g4 = 0; g4 < 4; ++g4) {
#pragma unroll
                for (int s = 0; s < 4; ++s) asm volatile("" : "+v"(kf[g4][s]));
                f32x4 a = (f32x4){0.f, 0.f, 0.f, 0.f};
#pragma unroll
                for (int s = 0; s < 4; ++s) a = __builtin_amdgcn_mfma_f32_16x16x32_bf16(kf[g4][s], Qf[s], a, 0, 0, 0);
                asm volatile("" : "+v"(a)); sr[4 * gq + g4] = a; }
        }
        float mx = -INFINITY;
#ifndef DSA_NOSM
#pragma unroll
        for (int g = 0; g < 16; ++g) { const v2u i4 = *(const LAS v2u*)(list + 16 * g + 4 * fq);
#pragma unroll
            for (int i = 0; i < 4; ++i) { const unsigned id = (i & 1) ? (i4[i >> 1] >> 16) : (i4[i >> 1] & 0xffffu); const bool ok = id != 0xFFFFu;
                const int rel = ok ? tok - (int)id : 0; const int bk = BUCK[rel];
                const float lg = ok ? sr[g][i] * 0.08838834764831845f + BIAS[bk * 16 + fr] : -INFINITY; sr[g][i] = lg; mx = fmaxf(mx, lg); }
            if (g & 1) __builtin_amdgcn_sched_barrier(0); }
#endif
        mx = fmaxf(mx, __shfl_xor(mx, 16)); mx = fmaxf(mx, __shfl_xor(mx, 32));
        float sum = 0.f;
#pragma unroll
        for (int g = 0; g < 16; ++g)
#pragma unroll
            for (int i = 0; i < 4; ++i) { const float e = __expf(sr[g][i] - mx); sr[g][i] = e; sum += e; }
        sum += __shfl_xor(sum, 16); sum += __shfl_xor(sum, 32);
        const float inv = 1.0f / sum;
        v4u pbs[8];
#pragma unroll
        for (int c8 = 0; c8 < 8; ++c8) { pbs[c8].x = pk2(sr[2 * c8][0], sr[2 * c8][1]); pbs[c8].y = pk2(sr[2 * c8][2], sr[2 * c8][3]); pbs[c8].z = pk2(sr[2 * c8 + 1][0], sr[2 * c8 + 1][1]); pbs[c8].w = pk2(sr[2 * c8 + 1][2], sr[2 * c8 + 1][3]); asm volatile("" : "+v"(pbs[c8])); }
        f32x4 O[8];
#pragma unroll
        for (int c = 0; c < 8; ++c) O[c] = (f32x4){0.f, 0.f, 0.f, 0.f};
#ifndef DSA_NOPV
        LAS unsigned char* VTw = VT + fq * VT_P + fr * 16;
        LAS unsigned char* VTr = VT + (8 * fq + ((lane_a & 15) >> 2)) * VT_P + 8 * (lane_a & 3);
        v4u vreg[8];
#pragma unroll
        for (int i = 0; i < 8; ++i) { const int rho = 4 * i + fq;
            const unsigned id = list[16 * ((rho >> 2) & 1) + 4 * (rho >> 3) + (rho & 3)]; const unsigned key = id == 0xFFFFu ? 0u : id;
            vreg[i] = *(const v4u*)(proj + (rowb + key) * NP + C_V + 8 * fr); }
#pragma unroll
        for (int c8 = 0; c8 < 8; ++c8) {
            asm volatile("" ::: "memory");
#pragma unroll
            for (int i = 0; i < 8; ++i) { asm volatile("" : "+v"(vreg[i])); *(LAS v4u*)(VTw + i * (4 * VT_P)) = vreg[i]; }
            asm volatile("s_waitcnt lgkmcnt(0)" ::: "memory");
            if (c8 < 7) {
#pragma unroll
                for (int i = 0; i < 8; ++i) { const int rho = 4 * i + fq;
                    const unsigned id = list[16 * (2 * (c8 + 1) + ((rho >> 2) & 1)) + 4 * (rho >> 3) + (rho & 3)]; const unsigned key = id == 0xFFFFu ? 0u : id;
                    vreg[i] = *(const v4u*)(proj + (rowb + key) * NP + C_V + 8 * fr); }
            }
            const bf16x8 pb = __builtin_bit_cast(bf16x8, pbs[c8]);
#pragma unroll
            for (int c = 0; c < 8; ++c) {
                const v4i16_t x0 = __builtin_amdgcn_ds_read_tr16_b64_v4i16((LAS v4i16_t*)(VTr + 32 * c)), x1 = __builtin_amdgcn_ds_read_tr16_b64_v4i16((LAS v4i16_t*)(VTr + 4 * VT_P + 32 * c));
                bf16x8 va; va[0] = x0[0]; va[1] = x0[1]; va[2] = x0[2]; va[3] = x0[3]; va[4] = x1[0]; va[5] = x1[1]; va[6] = x1[2]; va[7] = x1[3];
                O[c] = __builtin_amdgcn_mfma_f32_16x16x32_bf16(va, pb, O[c], 0, 0, 0); if (c == 3) __builtin_amdgcn_sched_barrier(0); }
            asm volatile("s_waitcnt lgkmcnt(0)" ::: "memory");
        }
#endif
        bf16* op = proj + (rowb + tok) * NP + C_Q + fr * 128 + 4 * fq;
#pragma unroll
        for (int c = 0; c < 8; ++c) { v2u w; w.x = pk2(O[c][0] * inv, O[c][1] * inv); w.y = pk2(O[c][2] * inv, O[c][3] * inv); if (STORE || w.x == 0x12345678u) *(v2u*)(op + 16 * c) = w; }
    }
#endif
}
#ifndef PHM
#define PHM 0xFFFF
#endif
#ifndef DUP_P1
#define DUP_P1 0
#endif
#ifndef DUP_LRU
#define DUP_LRU 0
#endif
#ifndef DUP_DSA
#define DUP_DSA 0
#endif
#define GBAR() do { TIDS(); XcdBarrier b2_ = bar; asm volatile("" : "+s"(b2_.x)); xcd_barrier(b2_, tid); } while (0)
#define GEMM_PHASE(EpiT, g, E) do { pg8::StaticOrder S_; S_.init((g).M, (g).N, G, (int)blockIdx.x); TIDS(); pg8::gemm_phase<EpiT, pg8::StaticOrder, true, true>(lds, g, S_, E, tid); } while (0)
__global__ void __launch_bounds__(512, 2) fwd_kernel(P p) {
    extern __shared__ __attribute__((aligned(16))) unsigned char lds_raw[];
    LAS unsigned char* lds = (LAS unsigned char*)lds_raw;
    cg::grid_group grid = cg::this_grid();
    const int G = gridDim.x, NGW = G * 8;
    const int wave_s = __builtin_amdgcn_readfirstlane((int)(threadIdx.x >> 6));
    if (threadIdx.x < 2) ((LAS unsigned*)(lds + LDS_BYTES - 256))[threadIdx.x] = 0u;
    XcdBarrier bar = xcd_barrier_post((unsigned*)(p.ws + WS_CTL), (volatile LAS unsigned*)(lds + LDS_BYTES - 256), (int)threadIdx.x);
#define TIDS() unsigned om_ = 0xFFFFFFFFu; asm volatile("" : "+s"(om_)); int tid = wave_s * 64 + (int)__builtin_amdgcn_mbcnt_hi(om_, __builtin_amdgcn_mbcnt_lo(om_, 0u)); const int lane = tid & 63, wave = wave_s, gw = blockIdx.x * 8 + wave; (void)gw; (void)lane
    bf16* proj = (bf16*)(p.ws + WS_PROJ);
#if PHM & 1
    { TIDS(); phase0(p, lds, gw, NGW, lane, wave); }
#endif
    grid.sync();
#if PHM & 2
    { pg8::Gemm g{(const bf16*)(p.ws + WS_XB), (const bf16*)(p.ws + WS_WINT), T_, NP, D_, D_, 0}; pg8::EpiBf16<0> E{proj, NP, nullptr, 0, 0, 1.f}; GEMM_PHASE(pg8::EpiBf16<0>, g, E); }
#endif
    GBAR();
#if DUP_P1
    { pg8::Gemm g{(const bf16*)(p.ws + WS_XB), (const bf16*)(p.ws + WS_WINT), T_, NP, D_, D_, 0}; pg8::EpiBf16<0> E{proj, NP, nullptr, 0, 0, 1.f}; GEMM_PHASE(pg8::EpiBf16<0>, g, E); }
    GBAR();
#endif
#if PHM & 4
    { TIDS(); phase15(p, lds, gw, NGW, lane, wave); }
#endif
    GBAR();
#if DUP_LRU
    { TIDS(); for (int u = blockIdx.x; u < 256; u += G) lru_unit<false>(p, lds, u, tid, lane, wave); }
#endif
#if DUP_DSA
    { TIDS(); dsa_tables(p, lds, tid);
    for (int w = blockIdx.x; w < 256; w += G) { const int b = w >> 5, j = w & 31;
#pragma unroll 1
        for (int q = 0; q < 4; ++q) { const int tg = q == 0 ? j : q == 1 ? 63 - j : q == 2 ? 64 + j : 127 - j; dsa_unit<false>(p, lds, b, tg, lane, wave); } } __syncthreads(); }
#endif
#if PHM & 8
    { TIDS(); for (int u = blockIdx.x; u < 256; u += G) lru_unit<true>(p, lds, u, tid, lane, wave); }
#endif
#if PHM & 16
    { TIDS(); dsa_tables(p, lds, tid);
    for (int w = blockIdx.x; w < 256; w += G) { const int b = w >> 5, j = w & 31;
#pragma unroll 1
        for (int q = 0; q < 4; ++q) { const int tg = q == 0 ? j : q == 1 ? 63 - j : q == 2 ? 64 + j : 127 - j; dsa_unit<true>(p, lds, b, tg, lane, wave); } } }
#endif
    GBAR();
#if PHM & 32
    { pg8::Gemm g{proj + C_LG, (const bf16*)(p.ws + WS_WLA), T_, 2 * D_, D_, NP, (size_t)D_ * 2}; pg8::EpiMerge E{proj, NP, C_GL, C_GA, p.out, D_, proj, NP};
      pg8::PairOrder S_; S_.init(T_, D_, G, (int)blockIdx.x); TIDS(); pg8::gemm_phase<pg8::EpiMerge, pg8::PairOrder, true, true>(lds, g, S_, E, tid); }
#endif
    GBAR();
#if PHM & 64
    { pg8::Gemm g{proj, (const bf16*)(p.ws + WS_WOUT), T_, D_, D_, NP, 0}; pg8::EpiResid E{p.x, p.out, D_, ALPHA}; GEMM_PHASE(pg8::EpiResid, g, E); }
#endif
    GBAR();
    { TIDS(); ln_rows(p.out, (bf16*)(p.ws + WS_H1B), p.ln1_g, p.ln1_b, gw, NGW, lane); }
    GBAR();
#if PHM & 128
    { pg8::Gemm g{(const bf16*)(p.ws + WS_H1B), (const bf16*)(p.ws + WS_WUP), T_, FF2, D_, D_, 0}; pg8::EpiGeglu E{(bf16*)(p.ws + WS_ACT), FF, p.fc_w, p.fc_b, (float*)(p.ws + WS_HEAD), (float*)(p.ws + WS_TAIL), FF}; GEMM_PHASE(pg8::EpiGeglu, g, E); }
#endif
    GBAR();
    { TIDS(); ffn_fixup(p, blockIdx.x * 512 + tid, G * 512); }
    GBAR();
#if PHM & 256
    { pg8::Gemm g{(const bf16*)(p.ws + WS_ACT), (const bf16*)(p.ws + WS_WDN), T_, D_, FF, FF, 0}; pg8::EpiResid E{p.out, p.out, D_, ALPHA}; GEMM_PHASE(pg8::EpiResid, g, E); }
#endif
    GBAR();
    { TIDS(); ln_rows(p.out, nullptr, p.ln2_g, p.ln2_b, gw, NGW, lane); }
}

extern "C" void kernel_launch(void* const* d_in, const int* in_sizes, int n_in, void* d_out, int out_size, void* d_ws, size_t ws_size, hipStream_t stream) {
    static int grid = 0;
    if (grid == 0) {
        if (n_in != 23 || out_size != T_ * D_ || ws_size < WS_END) { fprintf(stderr, "kernel_launch: unexpected shapes (n_in %d out %d ws %zu)\n", n_in, out_size, ws_size); grid = -1; return; }
        int dev = 0, cus = 0, per_cu = 0;
        (void)hipGetDevice(&dev); (void)hipDeviceGetAttribute(&cus, hipDeviceAttributeMultiprocessorCount, dev);
        (void)hipFuncSetAttribute((const void*)fwd_kernel, hipFuncAttributeMaxDynamicSharedMemorySize, LDS_BYTES);
        if (hipOccupancyMaxActiveBlocksPerMultiprocessor(&per_cu, (const void*)fwd_kernel, 512, LDS_BYTES) != hipSuccess || per_cu < 1) per_cu = 1;
        (void)hipGetLastError();
        grid = cus * per_cu;
    }
    if (grid < 0) return;
    (void)hipMemsetAsync((char*)d_ws + WS_CTL, 0, 16384, stream);
    P p{};
    const float** pp = (const float**)&p;
    for (int i = 0; i < 23; ++i) pp[i] = (const float*)d_in[i];
    p.out = (float*)d_out; p.ws = (unsigned char*)d_ws;
    void* args[] = {&p};
    hipError_t e = hipLaunchCooperativeKernel((const void*)fwd_kernel, dim3(grid), dim3(512), args, LDS_BYTES, stream);
    if (e != hipSuccess) fprintf(stderr, "cooperative launch failed: %s (grid %d)\n", hipGetErrorString(e), grid);
}
```

```cpp
#include <hip/hip_runtime.h>
#include <hip/hip_cooperative_groups.h>
#include <cstdio>
#include <cstdint>
namespace cg = cooperative_groups;
namespace pg8 {
#define PG8_LAS __attribute__((address_space(3)))
typedef unsigned short bf16_t;
typedef short bf16x8 __attribute__((ext_vector_type(8)));
typedef float f32x4 __attribute__((ext_vector_type(4)));
typedef unsigned u32x4 __attribute__((ext_vector_type(4)));
constexpr int BM = 256, BK = 64, HALF = 128, HTB = HALF * BK * 2  , STAGE_BYTES = 8 * HTB, NXCD = 8, WGM = 8;

__host__ __device__ __forceinline__ int lds_byte(int r, int c) { const int st = (r >> 4) * 2 + (c >> 5), rr = r & 15, cc = c & 31, ob = rr * 64 + cc * 2; return st * 1024 + (ob ^ (((ob >> 9) & 1) << 5)); }
__host__ __device__ __forceinline__ void stage_rc(int b, int& R, int& C) { const int st = b / 1024, sb = b % 1024, swz = sb ^ (((sb >> 9) & 1) << 5); R = (st >> 1) * 16 + swz / 64; C = (st & 1) * 32 + (swz % 64) / 2; }
__host__ __device__ __forceinline__ int perm32(int rho) { const int n = rho >> 4, i = rho & 15; return 8 * (i >> 2) + 4 * n + (i & 3); }

struct Unit { int pm, pn; };
struct Gemm { const bf16_t* A; const bf16_t* Bt; int M, N, K, lda; size_t aalt; };

struct StaticOrder {
    int nM, nN, nwg, G, c;
    __host__ __device__ void init(int M, int N, int G_, int c_) { nM = M / BM; nN = N / BM; nwg = nM * nN; G = G_; c = c_; }
    __host__ __device__ bool next(int i, Unit& u) const {
        const long L = (long)i * G + c; if (L >= nwg) return false;
        int wgid = (int)L; { const int q = nwg / NXCD, r = nwg % NXCD, xcd = wgid % NXCD, off = wgid / NXCD; wgid = (xcd < r ? xcd * (q + 1) : r * (q + 1) + (xcd - r) * q) + off; }
        const int nig = WGM * nN, gid = wgid / nig, fm = gid * WGM, gsz = (nM - fm) < WGM ? (nM - fm) : WGM;
        u.pm = fm + ((wgid % nig) % gsz); u.pn = (wgid % nig) / gsz; return true;
    }
    __device__ __forceinline__ void a_ready(const Unit&) const {}
    __device__ __forceinline__ void done(const Unit&) const {}
};

__device__ __forceinline__ unsigned cvt_pk_bf16(float lo, float hi) { unsigned r; asm volatile("v_cvt_pk_bf16_f32 %0, %1, %2" : "=v"(r) : "v"(lo), "v"(hi)); return r; }
typedef float f32x2 __attribute__((ext_vector_type(2)));
__device__ __forceinline__ f32x2 gelu_pk(f32x2 v) {
    const f32x2 av = __builtin_elementwise_abs(v), d = av * 0.2316418882f + 1.0f;
    f32x2 t; t.x = __builtin_amdgcn_rcpf(d.x); t.y = __builtin_amdgcn_rcpf(d.y);
    f32x2 q = t * 0.5307027145f + (-0.7265760135f); q = q * t + 0.7107068705f; q = q * t + (-0.142248368f); q = q * t + 0.127414796f; q = q * t;
    const f32x2 s = (v * v) * (-0.72134752044f);
    f32x2 e; e.x = __builtin_amdgcn_exp2f(s.x); e.y = __builtin_amdgcn_exp2f(s.y);
    const f32x2 m = v * (q * e), r = v - m;
    f32x2 o; o.x = v.x < 0.f ? m.x : r.x; o.y = v.y < 0.f ? m.y : r.y; return o;
}

template <int ACT  > struct EpiBf16 {
    static constexpr bool PERM = true, AFTER_DRAIN = false, MID = false; static_assert(ACT == 0 || ACT == 1, "EpiBf16: ACT is 0 (none) or 1 (gelu_pk)");
    bf16_t* O; int ldc; const float* bias; int split_cols; size_t split_stride; float scale0;
    __device__ __forceinline__ void operator()(const f32x4 (&acc)[2][2][4][2], const Unit& u, int wr, int wc, int fr, int fq) const {
        const int row0 = u.pm * BM + wr * 64 + fr; int colt = u.pn * BM; bf16_t* base = O;
        float sc = 1.f; if (split_cols) { const int t = colt / split_cols; base += (size_t)t * split_stride; colt -= t * split_cols; if (t == 0) sc = scale0; }
        const int col0 = colt + wc * 32 + 8 * fq, bcol0 = u.pn * BM + wc * 32 + 8 * fq;
        f32x4 bv[2][2];
#pragma unroll
        for (int bj = 0; bj < 2; ++bj)
#pragma unroll
            for (int n = 0; n < 2; ++n) bv[bj][n] = bias ? *(const f32x4*)(bias + bcol0 + bj * HALF + 4 * n) : (f32x4){0.f, 0.f, 0.f, 0.f};
#pragma unroll
        for (int ai = 0; ai < 2; ++ai)
#pragma unroll
            for (int m = 0; m < 4; ++m) { bf16_t* rowp = base + (size_t)(row0 + ai * HALF + m * 16) * ldc + col0;
#pragma unroll
                for (int bj = 0; bj < 2; ++bj) { f32x4 v0 = acc[ai][bj][m][0] + bv[bj][0], v1 = acc[ai][bj][m][1] + bv[bj][1];
                    if (ACT == 1) { f32x2 a = gelu_pk((f32x2){v0[0], v0[1]}), b = gelu_pk((f32x2){v0[2], v0[3]}), c = gelu_pk((f32x2){v1[0], v1[1]}), d = gelu_pk((f32x2){v1[2], v1[3]});
                        v0 = (f32x4){a.x, a.y, b.x, b.y}; v1 = (f32x4){c.x, c.y, d.x, d.y}; }
                    v0 = v0 * sc; v1 = v1 * sc; u32x4 w; w.x = cvt_pk_bf16(v0[0], v0[1]); w.y = cvt_pk_bf16(v0[2], v0[3]); w.z = cvt_pk_bf16(v1[0], v1[1]); w.w = cvt_pk_bf16(v1[2], v1[3]);
                    *(u32x4*)(rowp + bj * HALF) = w; } }
    }
};

__device__ __forceinline__ float blo(unsigned u) { return __uint_as_float(u << 16); }
__device__ __forceinline__ float bhi(unsigned u) { return __uint_as_float(u & 0xffff0000u); }
struct PairOrder {
    int nM, nN, nwg, G, c;
    __host__ __device__ void init(int M, int N, int G_, int c_) { nM = M / BM; nN = N / BM; nwg = nM * nN; G = G_; c = c_; }
    __host__ __device__ bool next(int i, Unit& u) const {
        const long L = (long)(i >> 1) * G + c; if (L >= nwg) return false;
        int wgid = (int)L; { const int q = nwg / NXCD, r = nwg % NXCD, xcd = wgid % NXCD, off = wgid / NXCD; wgid = (xcd < r ? xcd * (q + 1) : r * (q + 1) + (xcd - r) * q) + off; }
        const int nig = WGM * nN, gid = wgid / nig, fm = gid * WGM, gsz = (nM - fm) < WGM ? (nM - fm) : WGM;
        u.pm = fm + ((wgid % nig) % gsz); u.pn = 2 * ((wgid % nig) / gsz) + (i & 1); return true;
    }
    __device__ __forceinline__ void a_ready(const Unit&) const {}
    __device__ __forceinline__ void done(const Unit&) const {}
};
struct EpiMerge {
    static constexpr bool PERM = true, AFTER_DRAIN = false, MID = false;
    const bf16_t* G; int ldg, cgl, cga; float* tmp; int ldt; bf16_t* O; int ldc;
    __device__ __forceinline__ void operator()(f32x4 (&acc)[2][2][4][2], const Unit& u, int wr, int wc, int fr, int fq) const {
        const int sel = u.pn & 1; const int row0 = u.pm * BM + wr * 64 + fr, col0 = (u.pn >> 1) * BM + wc * 32 + 8 * fq; const int cg = sel ? cga : cgl;
        u32x4 L[2][2];
        { const bf16_t* rowp = G + (size_t)row0 * ldg + col0 + cg; L[0][0] = *(const u32x4*)(rowp); L[0][1] = *(const u32x4*)(rowp + HALF); }
#pragma unroll
        for (int idx = 0; idx < 8; ++idx) { const int ai = idx >> 2, m = idx & 3; const size_t r = (size_t)(row0 + ai * HALF + m * 16);
            if (idx < 7) { const int ai2 = (idx + 1) >> 2, m2 = (idx + 1) & 3; const bf16_t* rowp = G + (size_t)(row0 + ai2 * HALF + m2 * 16) * ldg + col0 + cg;
                L[(idx + 1) & 1][0] = *(const u32x4*)(rowp); L[(idx + 1) & 1][1] = *(const u32x4*)(rowp + HALF); }
#pragma unroll
            for (int bj = 0; bj < 2; ++bj) { u32x4 ga = L[idx & 1][bj];
                asm volatile("" : "+v"(ga));
                f32x4 o0, o1;
#pragma unroll
                for (int k = 0; k < 4; ++k) { const unsigned a = ga[k];
                    const float s0 = __builtin_amdgcn_rcpf(1.0f + __expf(-blo(a))), s1 = __builtin_amdgcn_rcpf(1.0f + __expf(-bhi(a)));
                    if (k < 2) { o0[2 * k] = acc[ai][bj][m][0][2 * k] * s0; o0[2 * k + 1] = acc[ai][bj][m][0][2 * k + 1] * s1; }
                    else { o1[2 * k - 4] = acc[ai][bj][m][1][2 * k - 4] * s0; o1[2 * k - 3] = acc[ai][bj][m][1][2 * k - 3] * s1; } }
                float* tp = tmp + r * ldt + col0 + bj * HALF;
                if (sel == 0) { *(f32x4*)tp = o0; *(f32x4*)(tp + 4) = o1; }
                else { const f32x4 t0 = *(const f32x4*)tp, t1 = *(const f32x4*)(tp + 4); o0 += t0; o1 += t1;
                    u32x4 w; w.x = cvt_pk_bf16(o0[0], o0[1]); w.y = cvt_pk_bf16(o0[2], o0[3]); w.z = cvt_pk_bf16(o1[0], o1[1]); w.w = cvt_pk_bf16(o1[2], o1[3]);
                    *(u32x4*)(O + r * ldc + col0 + bj * HALF) = w; } } }
    }
};
struct EpiResid {
    static constexpr bool PERM = false, AFTER_DRAIN = false, MID = false;
    const float* base; float* out; int ldc; float alpha;
    __device__ __forceinline__ void operator()(f32x4 (&acc)[2][2][4][2], const Unit& u, int wr, int wc, int fr, int fq) const {
        const int row0 = u.pm * BM + wr * 64 + fr, col0 = u.pn * BM + wc * 32 + 4 * fq;
#pragma unroll
        for (int ai = 0; ai < 2; ++ai)
#pragma unroll
            for (int m = 0; m < 4; ++m) { const size_t off = (size_t)(row0 + ai * HALF + m * 16) * ldc + col0;
#pragma unroll
                for (int bj = 0; bj < 2; ++bj)
#pragma unroll
                    for (int n = 0; n < 2; ++n) { const f32x4 bs = *(const f32x4*)(base + off + bj * HALF + n * 16); *(f32x4*)(out + off + bj * HALF + n * 16) = bs * alpha + acc[ai][bj][m][n]; } }
    }
};
__device__ __forceinline__ float dpp_prev1(float cur, float prev) {
    const int o = __builtin_amdgcn_update_dpp(0, __builtin_bit_cast(int, prev), 0x10F, 0xf, 0xf, true);
    return __builtin_bit_cast(float, __builtin_amdgcn_update_dpp(o, __builtin_bit_cast(int, cur), 0x111, 0xf, 0xf, false));
}
__device__ __forceinline__ float dpp_prev2(float cur, float prev) {
    const int o = __builtin_amdgcn_update_dpp(0, __builtin_bit_cast(int, prev), 0x10E, 0xf, 0xf, true);
    return __builtin_bit_cast(float, __builtin_amdgcn_update_dpp(o, __builtin_bit_cast(int, cur), 0x112, 0xf, 0xf, false));
}
struct EpiGeglu {
    static constexpr bool PERM = true, AFTER_DRAIN = false, MID = false;
    bf16_t* act; int ldact; const float* cw; const float* cb; float* head; float* tail; int nch;
    __device__ __forceinline__ void operator()(f32x4 (&acc)[2][2][4][2], const Unit& u, int wr, int wc, int fr, int fq) const {
        const int chb = u.pn * HALF + wc * 32 + 8 * fq;
        if (fr < 2 || fr >= 14) { const bool hd = fr < 2; float* eb = hd ? head : tail; const int er = hd ? fr : fr - 14;
#pragma unroll
            for (int ai = 0; ai < 2; ++ai) { float* ep = eb + ((size_t)(u.pm * 4 + ai * 2 + wr) * 2 + er) * (2 * nch) + u.pn * BM + wc * 32 + 8 * fq;
#pragma unroll
                for (int bj = 0; bj < 2; ++bj)
#pragma unroll
                    for (int n = 0; n < 2; ++n) { const f32x4 v0 = acc[ai][bj][0][n], v3 = acc[ai][bj][3][n]; f32x4 v; v[0] = hd ? v0[0] : v3[0]; v[1] = hd ? v0[1] : v3[1]; v[2] = hd ? v0[2] : v3[2]; v[3] = hd ? v0[3] : v3[3];
                        *(f32x4*)(ep + bj * HALF + 4 * n) = v; } } }
        __builtin_amdgcn_sched_barrier(0);
        f32x4 W[2][4];
        { const int cc = chb; W[0][0] = *(const f32x4*)(cw + cc); W[0][1] = *(const f32x4*)(cw + 2 * nch + cc); W[0][2] = *(const f32x4*)(cw + 4 * nch + cc); W[0][3] = *(const f32x4*)(cb + cc); }
#pragma unroll
        for (int idx = 0; idx < 4; ++idx) { const int n = idx >> 1, bj = idx & 1;
            if (idx < 3) { const int cc = ((idx + 1) & 1) * nch + chb + 4 * ((idx + 1) >> 1);
                W[(idx + 1) & 1][0] = *(const f32x4*)(cw + cc); W[(idx + 1) & 1][1] = *(const f32x4*)(cw + 2 * nch + cc); W[(idx + 1) & 1][2] = *(const f32x4*)(cw + 4 * nch + cc); W[(idx + 1) & 1][3] = *(const f32x4*)(cb + cc); }
            f32x4 w0 = W[idx & 1][0], w1 = W[idx & 1][1], w2 = W[idx & 1][2], bb = W[idx & 1][3];
            asm volatile("" : "+v"(w0), "+v"(w1), "+v"(w2), "+v"(bb));
#pragma unroll
            for (int ai = 0; ai < 2; ++ai) {
#pragma unroll
                for (int m = 3; m >= 0; --m) {
                    const f32x4 cur = acc[ai][bj][m][n], prv = acc[ai][bj][m > 0 ? m - 1 : 0][n]; f32x4 o;
#pragma unroll
                    for (int k = 0; k < 4; ++k) { const float p1 = dpp_prev1(cur[k], prv[k]), p2 = dpp_prev2(cur[k], prv[k]); o[k] = bb[k] + w0[k] * p2 + w1[k] * p1 + w2[k] * cur[k]; }
                    asm volatile("" : "+v"(o));
                    acc[ai][bj][m][n] = o;
                }
            }
            if (bj == 1) {
#pragma unroll
                for (int ai = 0; ai < 2; ++ai)
#pragma unroll
                    for (int m = 0; m < 4; ++m) { const f32x4 g = acc[ai][0][m][n], v = acc[ai][1][m][n]; f32x4 o;
#pragma unroll
                        for (int k = 0; k < 4; ++k) { const float x = g[k]; const float e = __builtin_amdgcn_exp2f(-x * (2.3022082f + 0.10294324f * x * x)); o[k] = x * v[k] * __builtin_amdgcn_rcpf(1.0f + e); }
                        asm volatile("" : "+v"(o));
                        acc[ai][0][m][n] = o; }
            }
        }
        const int row0 = u.pm * BM + wr * 64 + fr;
#pragma unroll
        for (int ai = 0; ai < 2; ++ai)
#pragma unroll
            for (int m = 0; m < 4; ++m) { const f32x4 a = acc[ai][0][m][0], b = acc[ai][0][m][1];
                u32x4 w; w.x = cvt_pk_bf16(a[0], a[1]); w.y = cvt_pk_bf16(a[2], a[3]); w.z = cvt_pk_bf16(b[0], b[1]); w.w = cvt_pk_bf16(b[2], b[3]);
                *(u32x4*)(act + (size_t)(row0 + ai * HALF + m * 16) * ldact + chb) = w; }
    }
};
template <class Epi, class Sched, bool ALIGN_EPI = false, bool SP2 = false>
__device__ __forceinline__ void gemm_phase(PG8_LAS unsigned char* lds, const Gemm g, const Sched& S, const Epi& E, int tid_in) {
    int tid_l = tid_in; asm volatile("" : "+v"(tid_l));
    const int tid = tid_l, wid = __builtin_amdgcn_readfirstlane(tid >> 6), lane = tid & 63, wr = wid >> 2, wc = wid & 3, fr = lane & 15, fq = lane >> 4;
    const int K = g.K, nt = K / BK;
    unsigned voffA[2], voffB[2];
#pragma unroll
    for (int i = 0; i < 2; ++i) { int R, C; stage_rc(tid * 16 + i * 8192, R, C); const int Rb = Epi::PERM ? ((R & ~31) + perm32(R & 31)) : R;
        voffA[i] = (unsigned)(R * g.lda + C) * 2u; voffB[i] = (unsigned)(Rb * K + C) * 2u; }
    const size_t kstep = (size_t)(BK * 2);
    const size_t hstep = (size_t)HALF * K * 2; const size_t hstepA = (size_t)HALF * g.lda * 2; const size_t tstepA = 2 * hstepA;
    const size_t tstep = 2 * hstep;
    const unsigned ldsw = (unsigned)wid * 1024u;
    const int aoff = lds_byte(wr * 64 + fr, fq * 8), boff = lds_byte(wc * 32 + fr, fq * 8);
#define PG8_SA(b, h) (((b) * 2 + (h)) * HTB)
#define PG8_SB(b, h) ((4 + (b) * 2 + (h)) * HTB)
#define PG8_STAGE(bufoff, gbase, voff) do { _Pragma("unroll") for (int _i = 0; _i < 2; ++_i) \
        __builtin_amdgcn_global_load_lds((const unsigned*)((const char*)(gbase) + (voff)[_i]), (PG8_LAS unsigned*)(lds + (bufoff) + ldsw + _i * 8192), 16, 0, 0); } while (0)
#define PG8_LDA(dst, b, h) do { _Pragma("unroll") for (int m = 0; m < 4; ++m) _Pragma("unroll") for (int k = 0; k < 2; ++k) dst[m][k] = *(const PG8_LAS bf16x8*)(lds + PG8_SA(b, h) + aoff + m * 2048 + k * 1024); } while (0)
#define PG8_LDB(dst, b, h) do { _Pragma("unroll") for (int n = 0; n < 2; ++n) _Pragma("unroll") for (int k = 0; k < 2; ++k) dst[n][k] = *(const PG8_LAS bf16x8*)(lds + PG8_SB(b, h) + boff + n * 2048 + k * 1024); } while (0)
#define PG8_MMA(ai, bj, At, Bt) do { __builtin_amdgcn_s_setprio(1); _Pragma("unroll") for (int m = 0; m < 4; ++m) _Pragma("unroll") for (int n = 0; n < 2; ++n) _Pragma("unroll") for (int k = 0; k < 2; ++k) \
        acc[ai][bj][m][n] = __builtin_amdgcn_mfma_f32_16x16x32_bf16(Bt[n][k], At[m][k], acc[ai][bj][m][n], 0, 0, 0); __builtin_amdgcn_s_setprio(0); } while (0)
#define PG8_WAIT_V(n) asm volatile("s_waitcnt vmcnt(" #n ")" ::: "memory")
#define PG8_WAIT_L(n) asm volatile("s_waitcnt lgkmcnt(" #n ")" ::: "memory")
#define PG8_BAR __builtin_amdgcn_s_barrier()
#define PG8_SCHED __builtin_amdgcn_sched_barrier(0)
    Unit cur, nxt; int ui = 0;
    if (!S.next(0, cur)) return;
    f32x4 acc[2][2][4][2];
#pragma unroll
    for (int a = 0; a < 2; ++a)
#pragma unroll
        for (int b = 0; b < 2; ++b)
#pragma unroll
            for (int m = 0; m < 4; ++m)
#pragma unroll
                for (int n = 0; n < 2; ++n) acc[a][b][m][n] = (f32x4){0.f, 0.f, 0.f, 0.f};
    bf16x8 At[4][2], B0[2][2], B1[2][2];
    const char* cA = (const char*)g.A + (size_t)cur.pm * tstepA + (size_t)(cur.pn & 1) * g.aalt; const char* cB = (const char*)g.Bt + (size_t)cur.pn * tstep;
    S.a_ready(cur);
    if constexpr (SP2) {
        PG8_STAGE(PG8_SB(0, 0), cB, voffB); PG8_STAGE(PG8_SB(0, 1), cB + hstep, voffB); PG8_STAGE(PG8_SA(0, 0), cA, voffA); PG8_STAGE(PG8_SA(0, 1), cA + hstepA, voffA);
        if (wr == 1) PG8_BAR;
        PG8_WAIT_V(2); PG8_BAR;
        PG8_STAGE(PG8_SB(1, 0), cB + kstep, voffB); PG8_STAGE(PG8_SA(1, 0), cA + kstep, voffA); PG8_STAGE(PG8_SB(1, 1), cB + hstep + kstep, voffB);
        PG8_WAIT_V(6); PG8_BAR;
    } else {
        PG8_STAGE(PG8_SB(0, 0), cB, voffB); PG8_STAGE(PG8_SA(0, 0), cA, voffA); PG8_STAGE(PG8_SB(0, 1), cB + hstep, voffB); PG8_STAGE(PG8_SA(0, 1), cA + hstepA, voffA);
        if (wr == 1) PG8_BAR;
        PG8_WAIT_V(4); PG8_BAR;
        PG8_STAGE(PG8_SB(1, 0), cB + kstep, voffB); PG8_STAGE(PG8_SA(1, 0), cA + kstep, voffA); PG8_STAGE(PG8_SB(1, 1), cB + hstep + kstep, voffB);
        PG8_WAIT_V(6); PG8_BAR;
    }
    for (;;) {
        const bool has_next = S.next(ui + 1, nxt);
        const char* nA = has_next ? (const char*)g.A + (size_t)nxt.pm * tstepA + (size_t)(nxt.pn & 1) * g.aalt : cA; const char* nB = has_next ? (const char*)g.Bt + (size_t)nxt.pn * tstep : cB;
        for (int t = 0; t < nt; t += 2) {
            const bool last = (t == nt - 2);
            const char* a1 = cA + (size_t)(t + 1) * kstep;
            const char* a2 = last ? nA : cA + (size_t)(t + 2) * kstep; const char* b2 = last ? nB : cB + (size_t)(t + 2) * kstep;
            const char* a3 = a2 + kstep; const char* b3 = b2 + kstep;
            if (last && has_next) S.a_ready(nxt);
            if constexpr (SP2) {
            PG8_LDB(B0, 0, 0); PG8_LDB(B1, 0, 1); PG8_SCHED; PG8_LDA(At, 0, 0); PG8_STAGE(PG8_SA(1, 1), a1 + hstepA, voffA);
            PG8_WAIT_V(8); PG8_WAIT_L(0); PG8_BAR; PG8_MMA(0, 0, At, B0); PG8_MMA(0, 1, At, B1); PG8_BAR; PG8_SCHED;
            PG8_LDA(At, 0, 1); PG8_STAGE(PG8_SB(0, 0), b2, voffB); PG8_STAGE(PG8_SB(0, 1), b2 + hstep, voffB); PG8_STAGE(PG8_SA(0, 0), a2, voffA);
            PG8_WAIT_V(8); PG8_WAIT_L(0); PG8_BAR; PG8_MMA(1, 0, At, B0); PG8_MMA(1, 1, At, B1); PG8_BAR; PG8_SCHED;
            PG8_LDB(B0, 1, 0); PG8_LDB(B1, 1, 1); PG8_SCHED; PG8_LDA(At, 1, 0); PG8_STAGE(PG8_SA(0, 1), a2 + hstepA, voffA);
            PG8_WAIT_V(8); PG8_WAIT_L(0); PG8_BAR; PG8_MMA(0, 0, At, B0); PG8_MMA(0, 1, At, B1); PG8_BAR; PG8_SCHED;
            PG8_LDA(At, 1, 1); PG8_STAGE(PG8_SB(1, 0), b3, voffB); PG8_STAGE(PG8_SB(1, 1), b3 + hstep, voffB); PG8_STAGE(PG8_SA(1, 0), a3, voffA);
            PG8_WAIT_V(8); PG8_WAIT_L(0); PG8_BAR; PG8_MMA(1, 0, At, B0); PG8_MMA(1, 1, At, B1); PG8_BAR; PG8_SCHED;
            } else {
            PG8_LDB(B0, 0, 0); PG8_SCHED; PG8_LDA(At, 0, 0); PG8_STAGE(PG8_SA(1, 1), a1 + hstepA, voffA);
            PG8_WAIT_L(8); PG8_BAR; PG8_WAIT_L(0); PG8_MMA(0, 0, At, B0); PG8_BAR; PG8_SCHED;
            PG8_LDB(B1, 0, 1); PG8_STAGE(PG8_SB(0, 0), b2, voffB);
            PG8_BAR; PG8_WAIT_L(0); PG8_MMA(0, 1, At, B1); PG8_BAR;
            PG8_LDA(At, 0, 1); PG8_STAGE(PG8_SA(0, 0), a2, voffA);
            PG8_BAR; PG8_WAIT_L(0); PG8_MMA(1, 0, At, B0); PG8_BAR; PG8_SCHED;
            PG8_STAGE(PG8_SB(0, 1), b2 + hstep, voffB);
            PG8_WAIT_V(6); PG8_BAR; PG8_MMA(1, 1, At, B1); PG8_BAR;
            PG8_LDB(B0, 1, 0); PG8_SCHED; PG8_LDA(At, 1, 0); PG8_STAGE(PG8_SA(0, 1), a2 + hstepA, voffA);
            PG8_WAIT_L(8); PG8_BAR; PG8_WAIT_L(0); PG8_MMA(0, 0, At, B0); PG8_BAR; PG8_SCHED;
            PG8_LDB(B1, 1, 1); PG8_STAGE(PG8_SB(1, 0), b3, voffB);
            PG8_BAR; PG8_WAIT_L(0); PG8_MMA(0, 1, At, B1); PG8_BAR;
            PG8_LDA(At, 1, 1); PG8_STAGE(PG8_SA(1, 0), a3, voffA);
            PG8_BAR; PG8_WAIT_L(0); PG8_MMA(1, 0, At, B0); PG8_BAR; PG8_SCHED;
            PG8_STAGE(PG8_SB(1, 1), b3 + hstep, voffB);
            PG8_WAIT_V(6); PG8_BAR; PG8_MMA(1, 1, At, B1); PG8_BAR;
            }
        }
        if constexpr (ALIGN_EPI) { if (wr == 0) PG8_BAR; }
        if constexpr (!Epi::AFTER_DRAIN) { E(acc, cur, wr, wc, fr, fq); S.done(cur); }
        if (!has_next) break;
#pragma unroll
        for (int a = 0; a < 2; ++a)
#pragma unroll
            for (int b = 0; b < 2; ++b)
#pragma unroll
                for (int m = 0; m < 4; ++m)
#pragma unroll
                    for (int n = 0; n < 2; ++n) acc[a][b][m][n] = (f32x4){0.f, 0.f, 0.f, 0.f};
        cur = nxt; cA = nA; cB = nB; ++ui;
        if constexpr (ALIGN_EPI) { if (wr == 1) PG8_BAR; }
    }
    PG8_WAIT_V(0);
    if constexpr (!ALIGN_EPI) { if (wr == 0) PG8_BAR; }
    PG8_BAR;
    if constexpr (Epi::AFTER_DRAIN) { E.fused(acc, cur, wr, wc, fr, fq, lds, wid, lane); S.done(cur); }
#undef PG8_SA
#undef PG8_SB
#undef PG8_STAGE
#undef PG8_LDA
#undef PG8_LDB
#undef PG8_MMA
#undef PG8_WAIT_V
#undef PG8_WAIT_L
#undef PG8_BAR
#undef PG8_SCHED
}
}
#define LAS __attribute__((address_space(3)))
typedef unsigned short bf16;
typedef unsigned v4u __attribute__((ext_vector_type(4)));
typedef unsigned v2u __attribute__((ext_vector_type(2)));
typedef float f32x4 __attribute__((ext_vector_type(4)));
typedef float f32x16 __attribute__((ext_vector_type(16)));
typedef short bf16x8 __attribute__((ext_vector_type(8)));
typedef short v4i16_t __attribute__((ext_vector_type(4)));
constexpr int NB = 8, S_ = 2048, D_ = 2048, T_ = NB * S_;
constexpr int NP = 11776;
constexpr int NIN = 11600;
constexpr int C_LX = 0, C_LG = 2048, C_Q = 4096, C_K = 6144, C_V = 6272, C_QI = 6400, C_KI = 7424, C_WI = 7488, C_GL = 7680, C_GA = 9728;
constexpr int FF = 6144, FF2 = 12288;
constexpr float LN_EPS = 1e-5f;
constexpr float ALPHA = 1.189207115f;
constexpr size_t MiB = 1u << 20;
constexpr size_t WS_WINT = 0, WS_XB = 48 * MiB;
constexpr size_t WS_WLA = 0, WS_WOUT = 16 * MiB, WS_WUP = 24 * MiB, WS_WDN = 72 * MiB;
constexpr size_t WS_PROJ = 112 * MiB;
constexpr size_t WS_KIN = 480 * MiB;
constexpr size_t WS_H1B = 112 * MiB, WS_ACT = 176 * MiB, WS_HEAD = 368 * MiB, WS_TAIL = 400 * MiB;
constexpr size_t WS_CTL = 482 * MiB;
constexpr size_t WS_END = 483 * MiB;
constexpr int LDS_BYTES = 147456;

__device__ __forceinline__ float bf_lo(unsigned u) { return __uint_as_float(u << 16); }
__device__ __forceinline__ float bf_hi(unsigned u) { return __uint_as_float(u & 0xffff0000u); }
__device__ __forceinline__ float bf1(bf16 h) { return __uint_as_float(((unsigned)h) << 16); }
__device__ __forceinline__ unsigned f2bf(float f) { unsigned u = __float_as_uint(f); return (u + 0x7fffu + ((u >> 16) & 1u)) >> 16; }
__device__ __forceinline__ unsigned pk2(float lo, float hi) { return pg8::cvt_pk_bf16(lo, hi); }
__device__ __forceinline__ float sigmoidf_(float x) { return __builtin_amdgcn_rcpf(1.0f + __expf(-x)); }
__device__ __forceinline__ float gelu_t(float x) { const float e = __builtin_amdgcn_exp2f(-x * (2.3022082f + 0.10294324f * x * x)); return x * __builtin_amdgcn_rcpf(1.0f + e); }
__device__ __forceinline__ float wave_sum(float v) {
#pragma unroll
    for (int o = 1; o < 64; o <<= 1) v += __shfl_xor(v, o);
    return v;
}
#define XB_TMO      128
#define XB_XCNT(j)  (256  + 64 * (j))
#define XB_XSUB(j)  (1280 + 64 * (j))
#define XB_XGEN(j)  (2304 + 64 * (j))
#define XB_TOP      3328
#define XB_TOPGEN   3392
#define XCD_BAR_WORDS 3456
#define XB_SPIN_CAP (1u << 18)

__device__ __forceinline__ unsigned xb_ld(unsigned* p)              { return __hip_atomic_load(p, __ATOMIC_RELAXED, __HIP_MEMORY_SCOPE_AGENT); }
__device__ __forceinline__ unsigned xb_add(unsigned* p, unsigned v) { return __hip_atomic_fetch_add(p, v, __ATOMIC_RELAXED, __HIP_MEMORY_SCOPE_AGENT); }
__device__ __forceinline__ unsigned xb_xcc_id() { return (unsigned)__builtin_amdgcn_s_getreg((3 << 11) | 20) & 0xFu; }
#define XB_SPIN(cond, bar) do { unsigned _sp = 0; while (cond) { __builtin_amdgcn_s_sleep(1); \
    if ((++_sp & 255u) == 0u) { if (xb_ld(&(bar)[XB_TMO])) break; if (_sp > XB_SPIN_CAP) { atomicAdd(&(bar)[XB_TMO], 1u); break; } } } } while (0)

struct XcdBarrier {
    unsigned* bar; unsigned x;
    volatile LAS unsigned* st;
};

__device__ __forceinline__ XcdBarrier xcd_barrier_post(unsigned* bar, volatile LAS unsigned* st, int tid) {
    XcdBarrier b; b.bar = bar; b.x = xb_xcc_id(); b.st = st;
    if (tid == 0) (void)xb_add(&bar[XB_XCNT(b.x)], 1u);
    return b;
}
__device__ __forceinline__ void xcd_barrier_complete(unsigned* bar, unsigned x, unsigned& nloc, unsigned& nx) {
    const unsigned G = gridDim.x * gridDim.y * gridDim.z;
    unsigned sum, cnt, mine, sp = 0u;
    for (;;) {
        sum = 0u; cnt = 0u; mine = 0u;
#pragma unroll
        for (unsigned j = 0; j < 16; ++j) { const unsigned c = xb_ld(&bar[XB_XCNT(j)]); sum += c; cnt += (c > 0u) ? 1u : 0u; mine = (j == x) ? c : mine; }
        if (sum == G) break;
        __builtin_amdgcn_s_sleep(1);
        if ((++sp & 255u) == 0u) { if (xb_ld(&bar[XB_TMO])) break; if (sp > XB_SPIN_CAP) { atomicAdd(&bar[XB_TMO], 1u); break; } }
    }
    nloc = mine > 0u ? mine : 1u; nx = cnt > 0u ? cnt : 1u;
}

__device__ __forceinline__ void xcd_barrier(const XcdBarrier& b, int tid) {
    asm volatile("s_waitcnt vmcnt(0)" ::: "memory");
    __syncthreads();
    if (tid == 0) {
        unsigned* bar = b.bar;
        __builtin_amdgcn_s_waitcnt(0);
        unsigned nloc = b.st[0], nx = b.st[1];
        if (nloc == 0u) { xcd_barrier_complete(bar, b.x, nloc, nx); b.st[0] = nloc; b.st[1] = nx; }
        const unsigned old = xb_add(&bar[XB_XSUB(b.x)], 1u);
        const unsigned gen = old / nloc;
        if (old + 1u == (gen + 1u) * nloc) {
            __builtin_amdgcn_fence(__ATOMIC_RELEASE, "agent");
            asm volatile("s_waitcnt vmcnt(0)" ::: "memory");
            const unsigned og = xb_add(&bar[XB_TOP], 1u);
            const unsigned tg = og / nx;
            if (og + 1u == (tg + 1u) * nx) xb_add(&bar[XB_TOPGEN], 1u);
            else XB_SPIN(xb_ld(&bar[XB_TOPGEN]) == tg, bar);
            __builtin_amdgcn_fence(__ATOMIC_ACQUIRE, "agent");
            xb_add(&bar[XB_XGEN(b.x)], 1u);
            asm volatile("s_waitcnt vmcnt(0)" ::: "memory");
        } else {
            XB_SPIN(xb_ld(&bar[XB_XGEN(b.x)]) == gen, bar);
            __builtin_amdgcn_fence(__ATOMIC_ACQUIRE, "agent");
            asm volatile("s_waitcnt vmcnt(0)" ::: "memory");
        }
    }
    __syncthreads();
}
struct P {
    const float *x, *w_in, *lru_conv_w, *lru_conv_b, *ga_w, *ga_b, *gx_w, *gx_b, *lam, *kn_g, *kn_b, *rel_bias, *w_pl, *w_pa, *w_out, *ln1_g, *ln1_b, *w_up, *fc_w, *fc_b, *w_dn, *ln2_g, *ln2_b;
    float* out; unsigned char* ws;
};
template <class MapN>
__device__ __forceinline__ void transpose_item(const float* W, int N, bf16* WT, int ldk, int koff, LAS float* scr, int kb, int nb, int lane, MapN map) {
    const int k0 = 64 * kb, n0 = 32 * nb; const int c4 = lane & 7, nn = n0 + 4 * c4;
    f32x4 v[8];
#pragma unroll
    for (int i = 0; i < 8; ++i) { const int kk = 8 * i + (lane >> 3); v[i] = nn < N ? *(const f32x4*)(W + (size_t)(k0 + kk) * N + nn) : (f32x4){0.f, 0.f, 0.f, 0.f}; }
#pragma unroll
    for (int i = 0; i < 8; ++i) { const int kk = 8 * i + (lane >> 3); LAS float* d = scr + kk * 33 + 4 * c4; d[0] = v[i][0]; d[1] = v[i][1]; d[2] = v[i][2]; d[3] = v[i][3]; }
    asm volatile("s_waitcnt lgkmcnt(0)" ::: "memory");
    const int c = lane & 7;
#pragma unroll
    for (int j = 0; j < 4; ++j) { const int n = (lane >> 3) + 8 * j; const LAS float* s = scr + (8 * c) * 33 + n;
        v4u o; o.x = pk2(s[0 * 33], s[1 * 33]); o.y = pk2(s[2 * 33], s[3 * 33]); o.z = pk2(s[4 * 33], s[5 * 33]); o.w = pk2(s[6 * 33], s[7 * 33]);
        if (n0 + n < N) *(v4u*)(WT + (size_t)map(n0 + n) * ldk + koff + k0 + 8 * c) = o; }
    asm volatile("s_waitcnt lgkmcnt(0)" ::: "memory");
}
struct MapId { __device__ __forceinline__ int operator()(int n) const { return n; } };
struct MapPair { int sel; __device__ __forceinline__ int operator()(int n) const { return 512 * (n >> 8) + 256 * sel + (n & 255); } };
struct MapIn { __device__ __forceinline__ int operator()(int n) const { return n < 7504 ? n : n + 176; } };
struct MapUp { __device__ __forceinline__ int operator()(int n) const { const int v = n >= FF ? 1 : 0, j = n - v * FF; return 256 * (j >> 7) + 128 * v + (j & 127); } };

__device__ __forceinline__ void phase0(const P& p, LAS unsigned char* lds, int gw, int NGW, int lane, int wave) {
    LAS float* scr = (LAS float*)(lds + wave * 16384);
    bf16* winT = (bf16*)(p.ws + WS_WINT);
    constexpr int NBLK = (NIN + 31) / 32;
    for (int it = gw; it < 32 * NBLK; it += NGW) transpose_item(p.w_in, NIN, winT, D_, 0, scr, it / NBLK, it % NBLK, lane, MapIn());
    for (int i = gw * 64 + lane; i < 176 * D_ / 8; i += NGW * 64) *(v4u*)(winT + (size_t)7504 * D_ + (size_t)i * 8) = (v4u){0u, 0u, 0u, 0u};
    bf16* xb = (bf16*)(p.ws + WS_XB);
    {   const size_t NT = (size_t)NGW * 64, n8 = (size_t)T_ * D_ / 8;
        for (size_t i = (size_t)gw * 64 + lane; i < n8; i += 4 * NT) {
            f32x4 a[4], b[4];
#pragma unroll
            for (int q = 0; q < 4; ++q) { const size_t j = i + q * NT; if (j < n8) { a[q] = *(const f32x4*)(p.x + j * 8); b[q] = *(const f32x4*)(p.x + j * 8 + 4); } }
#pragma unroll
            for (int q = 0; q < 4; ++q) { const size_t j = i + q * NT; if (j < n8) { v4u o; o.x = pk2(a[q][0], a[q][1]); o.y = pk2(a[q][2], a[q][3]); o.z = pk2(b[q][0], b[q][1]); o.w = pk2(b[q][2], b[q][3]); *(v4u*)(xb + j * 8) = o; } }
        } }
}
__device__ __forceinline__ void phase15(const P& p, LAS unsigned char* lds, int gw, int NGW, int lane, int wave) {
    LAS float* scr = (LAS float*)(lds + wave * 16384);
    bf16* wla = (bf16*)(p.ws + WS_WLA); bf16* wout = (bf16*)(p.ws + WS_WOUT); bf16* wup = (bf16*)(p.ws + WS_WUP); bf16* wdn = (bf16*)(p.ws + WS_WDN);
    constexpr int I_SQ = 32 * 64, I_UP = 32 * (FF2 / 32), I_DN = (FF / 64) * 64;
    constexpr int NIT = 3 * I_SQ + I_UP + I_DN;
    for (int it = gw; it < NIT; it += NGW) {
        int r = it;
        if (r < I_SQ) { transpose_item(p.w_pl, D_, wla, D_, 0, scr, r / 64, r % 64, lane, MapPair{0}); continue; } r -= I_SQ;
        if (r < I_SQ) { transpose_item(p.w_pa, D_, wla, D_, 0, scr, r / 64, r % 64, lane, MapPair{1}); continue; } r -= I_SQ;
        if (r < I_SQ) { transpose_item(p.w_out, D_, wout, D_, 0, scr, r / 64, r % 64, lane, MapId()); continue; } r -= I_SQ;
        if (r < I_UP) { transpose_item(p.w_up, FF2, wup, D_, 0, scr, r / (FF2 / 32), r % (FF2 / 32), lane, MapUp()); continue; } r -= I_UP;
        transpose_item(p.w_dn, D_, wdn, FF, 0, scr, r / 64, r % 64, lane, MapId());
    }
    const bf16* proj = (const bf16*)(p.ws + WS_PROJ); bf16* kin = (bf16*)(p.ws + WS_KIN);
    const float g = p.kn_g[lane], bta = p.kn_b[lane];
    for (int t = gw; t < T_; t += NGW) {
        const float v = bf1(proj[(size_t)t * NP + C_KI + lane]);
        const float mu = wave_sum(v) * (1.f / 64.f); const float d = v - mu; const float var = wave_sum(d * d) * (1.f / 64.f);
        kin[(size_t)t * 64 + lane] = (bf16)f2bf(d * __builtin_amdgcn_rsqf(var + LN_EPS) * g + bta);
    }
}
__device__ __forceinline__ void ln_rows(float* io, bf16* ob, const float* gam, const float* bet, int gw, int NGW, int lane) {
    for (int t = gw; t < T_; t += NGW) {
        f32x4* r = (f32x4*)(io + (size_t)t * D_) + lane; f32x4 v[8]; float s = 0.f;
#pragma unroll
        for (int j = 0; j < 8; ++j) { v[j] = r[64 * j]; s += (v[j][0] + v[j][1]) + (v[j][2] + v[j][3]); }
        const float mu = wave_sum(s) * (1.f / D_); float q = 0.f;
#pragma unroll
        for (int j = 0; j < 8; ++j) { v[j] = v[j] - mu; q += (v[j][0] * v[j][0] + v[j][1] * v[j][1]) + (v[j][2] * v[j][2] + v[j][3] * v[j][3]); }
        const float rstd = 1.0f / sqrtf(wave_sum(q) * (1.f / D_) + LN_EPS);
#pragma unroll
        for (int j = 0; j < 8; ++j) { const f32x4 g = *((const f32x4*)gam + lane + 64 * j), b = *((const f32x4*)bet + lane + 64 * j); const f32x4 o = v[j] * rstd * g + b; r[64 * j] = o;
            if (ob) { v2u w; w.x = pk2(o[0], o[1]); w.y = pk2(o[2], o[3]); *(v2u*)(ob + (size_t)t * D_ + 4 * (lane + 64 * j)) = w; } }
    }
}
__device__ __forceinline__ void ffn_fixup(const P& p, int gtid, int NT) {
    const float* head = (const float*)(p.ws + WS_HEAD); const float* tail = (const float*)(p.ws + WS_TAIL); bf16* act = (bf16*)(p.ws + WS_ACT);
    for (int i = gtid; i < (T_ / 64) * 2 * FF; i += NT) {
        const int j = i % FF, gr = i / FF, r = gr & 1, G = gr >> 1; const int tc = 256 * (j >> 7) + (j & 127);
        const bool first = (G & 31) == 0;
        float o2[2];
#pragma unroll
        for (int v = 0; v < 2; ++v) { const int c = tc + 128 * v, ch = j + v * FF;
            const float h0 = head[((size_t)G * 2 + 0) * FF2 + c], h1 = head[((size_t)G * 2 + 1) * FF2 + c];
            const float t0 = first ? 0.f : tail[((size_t)(G - 1) * 2 + 0) * FF2 + c], t1 = first ? 0.f : tail[((size_t)(G - 1) * 2 + 1) * FF2 + c];
            const float x0 = r ? h1 : h0, x1 = r ? h0 : t1, x2 = r ? t1 : t0;
            o2[v] = p.fc_b[ch] + p.fc_w[ch] * x2 + p.fc_w[FF2 + ch] * x1 + p.fc_w[2 * FF2 + ch] * x0; }
        act[(size_t)(G * 64 + r) * FF + j] = (bf16)f2bf(gelu_t(o2[0]) * o2[1]);
    }
}
template <bool STORE>
__device__ __forceinline__ void lru_unit(const P& p, LAS unsigned char* lds, int u, int tid, int lane, int wave) {
    constexpr int XA_P = 272;
    constexpr int GT_P = 132;
    LAS unsigned char* XA = lds;
    LAS float* XC = (LAS float*)(lds + 34816);
    LAS float* GT = (LAS float*)(lds + 67584);
    LAS float* SEGA = (LAS float*)(lds + 135168);
    LAS float* SEGH = SEGA + 512;
    LAS float* CAR = SEGH + 512;
    const int b = u >> 5, n = (u & 31) >> 1, half = u & 1, cin0 = 128 * n, cout0 = cin0 + 64 * half;
    bf16* proj = (bf16*)(p.ws + WS_PROJ);
    const int fr = lane & 15, fq = lane >> 4;
    bf16x8 Bf[4];
    { const float* Wg = (wave < 4 ? p.ga_w : p.gx_w) + (size_t)n * 128 * 128 + 64 * half + 16 * (wave & 3) + fr;
#pragma unroll
      for (int s = 0; s < 4; ++s) { unsigned w[4];
#pragma unroll
          for (int jj = 0; jj < 4; ++jj) w[jj] = pk2(Wg[(size_t)(32 * s + 8 * fq + 2 * jj) * 128], Wg[(size_t)(32 * s + 8 * fq + 2 * jj + 1) * 128]);
          Bf[s] = __builtin_bit_cast(bf16x8, (v4u){w[0], w[1], w[2], w[3]}); } }
    const int c = tid & 63, seg = tid >> 6;
    const float ba = p.ga_b[cout0 + c], bx = p.gx_b[cout0 + c];
    const float sp8 = -8.0f * log1pf(__expf(-p.lam[cout0 + c]));
    if (tid < 128) CAR[tid] = 0.f;
    const int cg8 = tid & 15, tg = tid >> 4;
    for (int ch = 0; ch < S_ / 128; ++ch) {
        const int tc0 = ch * 128;
        {
            float wj[4][8], bb[8];
#pragma unroll
            for (int j = 0; j < 4; ++j) { const f32x4 a = *(const f32x4*)(p.lru_conv_w + j * D_ + cin0 + 8 * cg8), d = *(const f32x4*)(p.lru_conv_w + j * D_ + cin0 + 8 * cg8 + 4);
#pragma unroll
                for (int e = 0; e < 4; ++e) { wj[j][e] = a[e]; wj[j][4 + e] = d[e]; } }
            { const f32x4 a = *(const f32x4*)(p.lru_conv_b + cin0 + 8 * cg8), d = *(const f32x4*)(p.lru_conv_b + cin0 + 8 * cg8 + 4);
#pragma unroll
              for (int e = 0; e < 4; ++e) { bb[e] = a[e]; bb[4 + e] = d[e]; } }
            float xr[7][8];
#pragma unroll
            for (int r = 0; r < 7; ++r) { const int t = tc0 + 4 * tg - 3 + r;
                v4u raw = (v4u){0u, 0u, 0u, 0u};
                if (t >= 0) raw = *(const v4u*)(proj + (size_t)(b * S_ + t) * NP + C_LX + cin0 + 8 * cg8);
#pragma unroll
                for (int k = 0; k < 4; ++k) { xr[r][2 * k] = bf_lo(raw[k]); xr[r][2 * k + 1] = bf_hi(raw[k]); } }
#pragma unroll
            for (int q = 0; q < 4; ++q) { float o[8];
#pragma unroll
                for (int e = 0; e < 8; ++e) o[e] = bb[e] + wj[0][e] * xr[q][e] + wj[1][e] * xr[q + 1][e] + wj[2][e] * xr[q + 2][e] + wj[3][e] * xr[q + 3][e];
                const int tok = 4 * tg + q;
                v4u w; w.x = pk2(o[0], o[1]); w.y = pk2(o[2], o[3]); w.z = pk2(o[4], o[5]); w.w = pk2(o[6], o[7]);
                *(LAS v4u*)(XA + tok * XA_P + cg8 * 16) = w;
                if ((cg8 >> 3) == half) { LAS float* xc = XC + tok * 64 + 8 * (cg8 & 7); *(LAS f32x4*)xc = (f32x4){o[0], o[1], o[2], o[3]}; *(LAS f32x4*)(xc + 4) = (f32x4){o[4], o[5], o[6], o[7]}; } }
        }
        bf16 lg[16];
#pragma unroll
        for (int k = 0; k < 16; ++k) lg[k] = proj[(size_t)(b * S_ + tc0 + 16 * seg + k) * NP + C_LG + cout0 + c];
        __syncthreads();
#pragma unroll
        for (int rt = 0; rt < 8; ++rt) { f32x4 acc = (f32x4){0.f, 0.f, 0.f, 0.f};
#pragma unroll
            for (int s = 0; s < 4; ++s) { const bf16x8 a = *(const LAS bf16x8*)(XA + (16 * rt + fr) * XA_P + (32 * s + 8 * fq) * 2); acc = __builtin_amdgcn_mfma_f32_16x16x32_bf16(a, Bf[s], acc, 0, 0, 0); }
#pragma unroll
            for (int i = 0; i < 4; ++i) GT[(16 * rt + 4 * fq + i) * GT_P + 16 * wave + fr] = acc[i]; }
        __syncthreads();
        float av[16], uv[16]; float hl = 0.f, Al = 1.f;
#pragma unroll
        for (int k = 0; k < 16; ++k) { const int tok = 16 * seg + k;
            const float r = sigmoidf_(GT[tok * GT_P + c] + ba), ii = sigmoidf_(GT[tok * GT_P + 64 + c] + bx);
            const float a = __expf(sp8 * r); float mult = sqrtf(fmaxf(1.0f - a * a, 0.f)); if (tc0 + tok == 0) mult = 1.0f;
            const float uu = mult * ii * XC[tok * 64 + c];
            av[k] = a; uv[k] = uu; hl = a * hl + uu; Al *= a; }
        SEGA[seg * 64 + c] = Al; SEGH[seg * 64 + c] = hl;
        __syncthreads();
        float cin = CAR[(ch & 1) * 64 + c];
        for (int s2 = 0; s2 < seg; ++s2) cin = SEGA[s2 * 64 + c] * cin + SEGH[s2 * 64 + c];
        if (seg == 7) CAR[((ch + 1) & 1) * 64 + c] = Al * cin + hl;
        float h = cin;
#pragma unroll
        for (int k = 0; k < 16; ++k) { h = av[k] * h + uv[k];
            const bf16 yv = (bf16)f2bf(gelu_t(bf1(lg[k])) * h); if (STORE || yv == 0x1234) proj[(size_t)(b * S_ + tc0 + 16 * seg + k) * NP + C_LG + cout0 + c] = yv; }
    }
    __syncthreads();
}
constexpr int A_VT = 0, VT_P = 288, A_LIST = 73728, A_BUCK = 81920, A_BIAS = 83968;
__device__ __forceinline__ unsigned offb(unsigned row, unsigned ch) { return 256u * row + 16u * (ch ^ (((row & 3) << 2) | ((row >> 2) & 3))); }
__device__ __forceinline__ void dsa_tables(const P& p, LAS unsigned char* lds, int tid) {
    LAS unsigned char* BUCK = lds + A_BUCK; LAS float* BIAS = (LAS float*)(lds + A_BIAS);
    for (int rel = tid; rel < S_; rel += 512) { int bk;
        if (rel < 16) bk = rel; else { const float nf = (float)rel; int lg = 16 + (int)(logf(nf / 16.0f) / 2.0794415416798357f * 16.0f); bk = lg < 31 ? lg : 31; }
        BUCK[rel] = (unsigned char)bk; }
    BIAS[tid] = p.rel_bias[tid];
    __syncthreads();
}
template <bool STORE>
__device__ __forceinline__ void dsa_unit(const P& p, LAS unsigned char* lds, int b, int tg, int lane, int wave) {
    bf16* proj = (bf16*)(p.ws + WS_PROJ); const bf16* kin = (const bf16*)(p.ws + WS_KIN);
    LAS unsigned short* LIST = (LAS unsigned short*)(lds + A_LIST) + wave * 512;
    LAS unsigned char* VT = lds + A_VT + wave * (32 * VT_P);
    const LAS unsigned char* BUCK = lds + A_BUCK; const LAS float* BIAS = (const LAS float*)(lds + A_BIAS);
    const int t0 = 16 * tg + 2 * wave;
    const size_t rowb = (size_t)b * S_;
    unsigned scr[64];
#ifdef DSA_NOIDX
#pragma unroll
    for (int j = 0; j < 64; ++j) scr[j] = lane * j;
#else
    {
        const int r = lane & 31, kh = lane >> 5;
        const int atok = t0 + ((r >> 2) & 1), ahead = 4 * (r >> 3) + (r & 3);
        bf16x8 Aq[4];
        { const bf16* qp = proj + (rowb + atok) * NP + C_QI + ahead * 64 + 32 * kh;
#pragma unroll
          for (int s = 0; s < 4; ++s) Aq[s] = *(const bf16x8*)(qp + 8 * s); }
        float wv[16];
        { const bf16* wp = proj + (rowb + t0 + kh) * NP + C_WI; const v4u w0 = *(const v4u*)wp, w1 = *(const v4u*)(wp + 8);
#pragma unroll
          for (int k = 0; k < 4; ++k) { wv[2 * k] = bf_lo(w0[k]) * 0.03125f; wv[2 * k + 1] = bf_hi(w0[k]) * 0.03125f; wv[8 + 2 * k] = bf_lo(w1[k]) * 0.03125f; wv[9 + 2 * k] = bf_hi(w1[k]) * 0.03125f; } }
        const int mytok = t0 + kh;
        const int ngrp = (t0 + 1) / 256 + 1;
#pragma unroll
        for (int g8 = 0; g8 < 8; ++g8) {
            if (g8 < ngrp) {
                bf16x8 kb[2][4];
                int l2 = lane; asm volatile("" : "+v"(l2));
                const bf16* kp = kin + (rowb + 32 * (g8 * 8) + (l2 & 31)) * 64 + 32 * (l2 >> 5);
                asm volatile("" : "+v"(kp));
#pragma unroll
                for (int s = 0; s < 4; ++s) kb[0][s] = *(const bf16x8*)(kp + 8 * s);
#pragma unroll
                for (int j = 0; j < 8; ++j) { const int blk = g8 * 8 + j, key = 32 * blk + r;
                    if (j < 7) { kp += 32 * 64; asm volatile("" : "+v"(kp));
#pragma unroll
                        for (int s = 0; s < 4; ++s) kb[(j + 1) & 1][s] = *(const bf16x8*)(kp + 8 * s); }
                    f32x16 acc;
#pragma unroll
                    for (int e = 0; e < 16; ++e) acc[e] = 0.f;
#pragma unroll
                    for (int s = 0; s < 4; ++s) acc = __builtin_amdgcn_mfma_f32_32x32x16_bf16(Aq[s], kb[j & 1][s], acc, 0, 0, 0);
                    float sc = 0.f;
#pragma unroll
                    for (int e = 0; e < 16; ++e) sc += wv[e] * fmaxf(acc[e], 0.f);
                    const unsigned ub = __float_as_uint(sc); const unsigned mono = ub ^ ((ub >> 31) ? 0xFFFFFFFFu : 0x80000000u);
                    unsigned sv = key <= mytok ? mono : 0u; asm volatile("" : "+v"(sv)); scr[blk] = sv;
                    __builtin_amdgcn_sched_barrier(0); }
            } else {
#pragma unroll
                for (int j = 0; j < 8; ++j) scr[g8 * 8 + j] = 0u;
            }
        }
    }
#endif
    {
        unsigned T = 0u;
        for (int bit = 31; bit >= 0; --bit) {
            const unsigned cand = T | (1u << bit); int clo = 0, chi = 0;
#pragma unroll
            for (int j = 0; j < 64; ++j) { const unsigned long long m = __ballot(scr[j] >= cand); clo += __popc((unsigned)m); chi += __popc((unsigned)(m >> 32)); }
            if ((lane < 32 ? clo : chi) >= 256) T = cand;
        }
        const unsigned Tm = T > 1u ? T : 1u;
        LAS unsigned short* mylist = LIST + (lane >> 5) * 256; int blo = 0, bhi = 0;
#pragma unroll
        for (int j = 0; j < 64; ++j) { const bool s = scr[j] >= Tm; const unsigned long long m = __ballot(s); const unsigned mlo = (unsigned)m, mhi = (unsigned)(m >> 32);
            const unsigned mm = lane < 32 ? mlo : mhi; const int pos = (lane < 32 ? blo : bhi) + __popc(mm & ((1u << (lane & 31)) - 1u));
            if (s && pos < 256) mylist[pos] = (unsigned short)(32 * j + (lane & 31));
            blo += __popc(mlo); bhi += __popc(mhi); }
        for (int q = (lane < 32 ? blo : bhi) + (lane & 31); q < 256; q += 32) mylist[q] = 0xFFFFu;
    }
    asm volatile("s_waitcnt lgkmcnt(0)" ::: "memory");
#ifndef DSA_NOATT
    int lane_a = lane; asm volatile("" : "+v"(lane_a));
    const int fr = lane_a & 15, fq = lane_a >> 4;
#pragma unroll 1
    for (int tt = 0; tt < 2; ++tt) {
        const int tok = t0 + tt; const LAS unsigned short* list = LIST + tt * 256;
        bf16x8 Qf[4];
        { const bf16* qp = proj + (rowb + tok) * NP + C_Q + fr * 128 + 32 * fq;
#pragma unroll
          for (int s = 0; s < 4; ++s) Qf[s] = *(const bf16x8*)(qp + 8 * s); }
        f32x4 sr[16];
#pragma unroll
        for (int gq = 0; gq < 4; ++gq) {
            bf16x8 kf[4][4];
#pragma unroll
            for (int g4 = 0; g4 < 4; ++g4) { const unsigned id = list[16 * (4 * gq + g4) + fr]; const unsigned key = id == 0xFFFFu ? 0u : id;
                const bf16* kp = proj + (rowb + key) * NP + C_K + 32 * fq;
#pragma unroll
                for (int s = 0; s < 4; ++s) kf[g4][s] = *(const bf16x8*)(kp + 8 * s); }
#pragma unroll
            for (int g4 = 0; g4 < 4; ++g4) {
#pragma unroll
                for (int s = 0; s < 4; ++s) asm volatile("" : "+v"(kf[g4][s]));
                f32x4 a = (f32x4){0.f, 0.f, 0.f, 0.f};
#pragma unroll
                for (int s = 0; s < 4; ++s) a = __builtin_amdgcn_mfma_f32_16x16x32_bf16(kf[g4][s], Qf[s], a, 0, 0, 0);
                asm volatile("" : "+v"(a)); sr[4 * gq + g4] = a; }
        }
        float mx = -INFINITY;
#ifndef DSA_NOSM
#pragma unroll
        for (int g = 0; g < 16; ++g) { const v2u i4 = *(const LAS v2u*)(list + 16 * g + 4 * fq);
#pragma unroll
            for (int i = 0; i < 4; ++i) { const unsigned id = (i & 1) ? (i4[i >> 1] >> 16) : (i4[i >> 1] & 0xffffu); const bool ok = id != 0xFFFFu;
                const int rel = ok ? tok - (int)id : 0; const int bk = BUCK[rel];
                const float lg = ok ? sr[g][i] * 0.08838834764831845f + BIAS[bk * 16 + fr] : -INFINITY; sr[g][i] = lg; mx = fmaxf(mx, lg); }
            if (g & 1) __builtin_amdgcn_sched_barrier(0); }
#endif
        mx = fmaxf(mx, __shfl_xor(mx, 16)); mx = fmaxf(mx, __shfl_xor(mx, 32));
        float sum = 0.f;
#pragma unroll
        for (int g = 0; g < 16; ++g)
#pragma unroll
            for (int i = 0; i < 4; ++i) { const float e = __expf(sr[g][i] - mx); sr[g][i] = e; sum += e; }
        sum += __shfl_xor(sum, 16); sum += __shfl_xor(sum, 32);
        const float inv = 1.0f / sum;
        v4u pbs[8];
#pragma unroll
        for (int c8 = 0; c8 < 8; ++c8) { pbs[c8].x = pk2(sr[2 * c8][0], sr[2 * c8][1]); pbs[c8].y = pk2(sr[2 * c8][2], sr[2 * c8][3]); pbs[c8].z = pk2(sr[2 * c8 + 1][0], sr[2 * c8 + 1][1]); pbs[c8].w = pk2(sr[2 * c8 + 1][2], sr[2 * c8 + 1][3]); asm volatile("" : "+v"(pbs[c8])); }
        f32x4 O[8];
#pragma unroll
        for (int c = 0; c < 8; ++c) O[c] = (f32x4){0.f, 0.f, 0.f, 0.f};
#ifndef DSA_NOPV
        LAS unsigned char* VTw = VT + fq * VT_P + fr * 16;
        LAS unsigned char* VTr = VT + (8 * fq + ((lane_a & 15) >> 2)) * VT_P + 8 * (lane_a & 3);
        v4u vreg[8];
#pragma unroll
        for (int i = 0; i < 8; ++i) { const int rho = 4 * i + fq;
            const unsigned id = list[16 * ((rho >> 2) & 1) + 4 * (rho >> 3) + (rho & 3)]; const unsigned key = id == 0xFFFFu ? 0u : id;
            vreg[i] = *(const v4u*)(proj + (rowb + key) * NP + C_V + 8 * fr); }
#pragma unroll
        for (int c8 = 0; c8 < 8; ++c8) {
            asm volatile("" ::: "memory");
#pragma unroll
            for (int i = 0; i < 8; ++i) { asm volatile("" : "+v"(vreg[i])); *(LAS v4u*)(VTw + i * (4 * VT_P)) = vreg[i]; }
            asm volatile("s_waitcnt lgkmcnt(0)" ::: "memory");
            if (c8 < 7) {
#pragma unroll
                for (int i = 0; i < 8; ++i) { const int rho = 4 * i + fq;
                    const unsigned id = list[16 * (2 * (c8 + 1) + ((rho >> 2) & 1)) + 4 * (rho >> 3) + (rho & 3)]; const unsigned key = id == 0xFFFFu ? 0u : id;
                    vreg[i] = *(const v4u*)(proj + (rowb + key) * NP + C_V + 8 * fr); }
            }
            const bf16x8 pb = __builtin_bit_cast(bf16x8, pbs[c8]);
#pragma unroll
            for (int c = 0; c < 8; ++c) {
                const v4i16_t x0 = __builtin_amdgcn_ds_read_tr16_b64_v4i16((LAS v4i16_t*)(VTr + 32 * c)), x1 = __builtin_amdgcn_ds_read_tr16_b64_v4i16((LAS v4i16_t*)(VTr + 4 * VT_P + 32 * c));
                bf16x8 va; va[0] = x0[0]; va[1] = x0[1]; va[2] = x0[2]; va[3] = x0[3]; va[4] = x1[0]; va[5] = x1[1]; va[6] = x1[2]; va[7] = x1[3];
                O[c] = __builtin_amdgcn_mfma_f32_16x16x32_bf16(va, pb, O[c], 0, 0, 0); if (c == 3) __builtin_amdgcn_sched_barrier(0); }
            asm volatile("s_waitcnt lgkmcnt(0)" ::: "memory");
        }
#endif
        bf16* op = proj + (rowb + tok) * NP + C_Q + fr * 128 + 4 * fq;
#pragma unroll
        for (int c = 0; c < 8; ++c) { v2u w; w.x = pk2(O[c][0] * inv, O[c][1] * inv); w.y = pk2(O[c][2] * inv, O[c][3] * inv); if (STORE || w.x == 0x12345678u) *(v2u*)(op + 16 * c) = w; }
    }
#endif
}
#ifndef PHM
#define PHM 0xFFFF
#endif
#ifndef ALIGN_P5
#define ALIGN_P5 true
#endif
#ifndef DUP_P5
#define DUP_P5 0
#endif
#ifndef DUP_P0
#define DUP_P0 0
#endif
#ifndef DUP_P15
#define DUP_P15 0
#endif
#ifndef DUP_P1
#define DUP_P1 0
#endif
#ifndef DUP_LRU
#define DUP_LRU 0
#endif
#ifndef DUP_DSA
#define DUP_DSA 0
#endif
#define GBAR() do { TIDS(); XcdBarrier b2_ = bar; asm volatile("" : "+s"(b2_.x)); xcd_barrier(b2_, tid); } while (0)
#define GEMM_PHASE_A(EpiT, g, E, AL) do { pg8::StaticOrder S_; S_.init((g).M, (g).N, G, (int)blockIdx.x); TIDS(); pg8::gemm_phase<EpiT, pg8::StaticOrder, AL, true>(lds, g, S_, E, tid); } while (0)
#define GEMM_PHASE(EpiT, g, E) GEMM_PHASE_A(EpiT, g, E, true)
__global__ void __launch_bounds__(512, 2) fwd_kernel(P p) {
    extern __shared__ __attribute__((aligned(16))) unsigned char lds_raw[];
    LAS unsigned char* lds = (LAS unsigned char*)lds_raw;
    cg::grid_group grid = cg::this_grid();
    const int G = gridDim.x, NGW = G * 8;
    const int wave_s = __builtin_amdgcn_readfirstlane((int)(threadIdx.x >> 6));
    if (threadIdx.x < 2) ((LAS unsigned*)(lds + LDS_BYTES - 256))[threadIdx.x] = 0u;
    XcdBarrier bar = xcd_barrier_post((unsigned*)(p.ws + WS_CTL), (volatile LAS unsigned*)(lds + LDS_BYTES - 256), (int)threadIdx.x);
#define TIDS() unsigned om_ = 0xFFFFFFFFu; asm volatile("" : "+s"(om_)); int tid = wave_s * 64 + (int)__builtin_amdgcn_mbcnt_hi(om_, __builtin_amdgcn_mbcnt_lo(om_, 0u)); const int lane = tid & 63, wave = wave_s, gw = blockIdx.x * 8 + wave; (void)gw; (void)lane
    bf16* proj = (bf16*)(p.ws + WS_PROJ);
#if PHM & 1
    { TIDS(); phase0(p, lds, gw, NGW, lane, wave); }
#if DUP_P0
    { TIDS(); phase0(p, lds, gw, NGW, lane, wave); }
#endif
#endif
    grid.sync();
#if PHM & 2
    { pg8::Gemm g{(const bf16*)(p.ws + WS_XB), (const bf16*)(p.ws + WS_WINT), T_, NP, D_, D_, 0}; pg8::EpiBf16<0> E{proj, NP, nullptr, 0, 0, 1.f}; GEMM_PHASE(pg8::EpiBf16<0>, g, E); }
#endif
    GBAR();
#if DUP_P1
    { pg8::Gemm g{(const bf16*)(p.ws + WS_XB), (const bf16*)(p.ws + WS_WINT), T_, NP, D_, D_, 0}; pg8::EpiBf16<0> E{proj, NP, nullptr, 0, 0, 1.f}; GEMM_PHASE(pg8::EpiBf16<0>, g, E); }
    GBAR();
#endif
#if PHM & 4
    { TIDS(); phase15(p, lds, gw, NGW, lane, wave); }
#if DUP_P15
    { TIDS(); phase15(p, lds, gw, NGW, lane, wave); }
#endif
#endif
    GBAR();
#if DUP_LRU
    { TIDS(); for (int u = blockIdx.x; u < 256; u += G) lru_unit<false>(p, lds, u, tid, lane, wave); }
#endif
#if DUP_DSA
    { TIDS(); dsa_tables(p, lds, tid);
    for (int w = blockIdx.x; w < 256; w += G) { const int b = w >> 5, j = w & 31;
#pragma unroll 1
        for (int q = 0; q < 4; ++q) { const int tg = q == 0 ? j : q == 1 ? 63 - j : q == 2 ? 64 + j : 127 - j; dsa_unit<false>(p, lds, b, tg, lane, wave); } } __syncthreads(); }
#endif
#if PHM & 8
    { TIDS(); for (int u = blockIdx.x; u < 256; u += G) lru_unit<true>(p, lds, u, tid, lane, wave); }
#endif
#if PHM & 16
    { TIDS(); dsa_tables(p, lds, tid);
    for (int w = blockIdx.x; w < 256; w += G) { const int b = w >> 5, j = w & 31;
#pragma unroll 1
        for (int q = 0; q < 4; ++q) { const int tg = q == 0 ? j : q == 1 ? 63 - j : q == 2 ? 64 + j : 127 - j; dsa_unit<true>(p, lds, b, tg, lane, wave); } } }
#endif
    GBAR();
#if PHM & 32
    { pg8::Gemm g{proj + C_LG, (const bf16*)(p.ws + WS_WLA), T_, 2 * D_, D_, NP, (size_t)D_ * 2}; pg8::EpiMerge E{proj, NP, C_GL, C_GA, p.out, D_, proj, NP};
      pg8::PairOrder S_; S_.init(T_, D_, G, (int)blockIdx.x); TIDS(); pg8::gemm_phase<pg8::EpiMerge, pg8::PairOrder, true, true>(lds, g, S_, E, tid); }
#endif
    GBAR();
#if PHM & 64
    { pg8::Gemm g{proj, (const bf16*)(p.ws + WS_WOUT), T_, D_, D_, NP, 0}; pg8::EpiResid E{p.x, p.out, D_, ALPHA}; GEMM_PHASE(pg8::EpiResid, g, E); }
#endif
    GBAR();
    { TIDS(); ln_rows(p.out, (bf16*)(p.ws + WS_H1B), p.ln1_g, p.ln1_b, gw, NGW, lane); }
    GBAR();
#if PHM & 128
    { pg8::Gemm g{(const bf16*)(p.ws + WS_H1B), (const bf16*)(p.ws + WS_WUP), T_, FF2, D_, D_, 0}; pg8::EpiGeglu E{(bf16*)(p.ws + WS_ACT), FF, p.fc_w, p.fc_b, (float*)(p.ws + WS_HEAD), (float*)(p.ws + WS_TAIL), FF}; GEMM_PHASE_A(pg8::EpiGeglu, g, E, ALIGN_P5); }
#if DUP_P5
    GBAR();
    { pg8::Gemm g{(const bf16*)(p.ws + WS_H1B), (const bf16*)(p.ws + WS_WUP), T_, FF2, D_, D_, 0}; pg8::EpiGeglu E{(bf16*)(p.ws + WS_ACT), FF, p.fc_w, p.fc_b, (float*)(p.ws + WS_HEAD), (float*)(p.ws + WS_TAIL), FF}; GEMM_PHASE_A(pg8::EpiGeglu, g, E, ALIGN_P5); }
#endif
#endif
    GBAR();
    { TIDS(); ffn_fixup(p, blockIdx.x * 512 + tid, G * 512); }
    GBAR();
#if PHM & 256
    { pg8::Gemm g{(const bf16*)(p.ws + WS_ACT), (const bf16*)(p.ws + WS_WDN), T_, D_, FF, FF, 0}; pg8::EpiResid E{p.out, p.out, D_, ALPHA}; GEMM_PHASE(pg8::EpiResid, g, E); }
#endif
    GBAR();
    { TIDS(); ln_rows(p.out, nullptr, p.ln2_g, p.ln2_b, gw, NGW, lane); }
}

extern "C" void kernel_launch(void* const* d_in, const int* in_sizes, int n_in, void* d_out, int out_size, void* d_ws, size_t ws_size, hipStream_t stream) {
    static int grid = 0;
    if (grid == 0) {
        if (n_in != 23 || out_size != T_ * D_ || ws_size < WS_END) { fprintf(stderr, "kernel_launch: unexpected shapes (n_in %d out %d ws %zu)\n", n_in, out_size, ws_size); grid = -1; return; }
        int dev = 0, cus = 0, per_cu = 0;
        (void)hipGetDevice(&dev); (void)hipDeviceGetAttribute(&cus, hipDeviceAttributeMultiprocessorCount, dev);
        (void)hipFuncSetAttribute((const void*)fwd_kernel, hipFuncAttributeMaxDynamicSharedMemorySize, LDS_BYTES);
        if (hipOccupancyMaxActiveBlocksPerMultiprocessor(&per_cu, (const void*)fwd_kernel, 512, LDS_BYTES) != hipSuccess || per_cu < 1) per_cu = 1;
        (void)hipGetLastError();
        grid = cus * per_cu;
    }
    if (grid < 0) return;
    (void)hipMemsetAsync((char*)d_ws + WS_CTL, 0, 16384, stream);
    P p{};
    const float** pp = (const float**)&p;
    for (int i = 0; i < 23; ++i) pp[i] = (const float*)d_in[i];
    p.out = (float*)d_out; p.ws = (unsigned char*)d_ws;
    void* args[] = {&p};
    hipError_t e = hipLaunchCooperativeKernel((const void*)fwd_kernel, dim3(grid), dim3(512), args, LDS_BYTES, stream);
    if (e != hipSuccess) fprintf(stderr, "cooperative launch failed: %s (grid %d)\n", hipGetErrorString(e), grid);
}
```

```cpp
#include <hip/hip_runtime.h>
#include <hip/hip_cooperative_groups.h>
#include <cstdio>
#include <cstdint>
namespace cg = cooperative_groups;
namespace pg8 {
#define PG8_LAS __attribute__((address_space(3)))
typedef unsigned short bf16_t;
typedef short bf16x8 __attribute__((ext_vector_type(8)));
typedef float f32x4 __attribute__((ext_vector_type(4)));
typedef unsigned u32x4 __attribute__((ext_vector_type(4)));
constexpr int BM = 256, BK = 64, HALF = 128, HTB = HALF * BK * 2  , STAGE_BYTES = 8 * HTB, NXCD = 8, WGM = 8;

__host__ __device__ __forceinline__ int lds_byte(int r, int c) { const int st = (r >> 4) * 2 + (c >> 5), rr = r & 15, cc = c & 31, ob = rr * 64 + cc * 2; return st * 1024 + (ob ^ (((ob >> 9) & 1) << 5)); }
__host__ __device__ __forceinline__ void stage_rc(int b, int& R, int& C) { const int st = b / 1024, sb = b % 1024, swz = sb ^ (((sb >> 9) & 1) << 5); R = (st >> 1) * 16 + swz / 64; C = (st & 1) * 32 + (swz % 64) / 2; }
__host__ __device__ __forceinline__ int perm32(int rho) { const int n = rho >> 4, i = rho & 15; return 8 * (i >> 2) + 4 * n + (i & 3); }

struct Unit { int pm, pn; };
struct Gemm { const bf16_t* A; const bf16_t* Bt; int M, N, K, lda; size_t aalt; };

struct StaticOrder {
    int nM, nN, nwg, G, c;
    __host__ __device__ void init(int M, int N, int G_, int c_) { nM = M / BM; nN = N / BM; nwg = nM * nN; G = G_; c = c_; }
    __host__ __device__ bool next(int i, Unit& u) const {
        const long L = (long)i * G + c; if (L >= nwg) return false;
        int wgid = (int)L; { const int q = nwg / NXCD, r = nwg % NXCD, xcd = wgid % NXCD, off = wgid / NXCD; wgid = (xcd < r ? xcd * (q + 1) : r * (q + 1) + (xcd - r) * q) + off; }
        const int nig = WGM * nN, gid = wgid / nig, fm = gid * WGM, gsz = (nM - fm) < WGM ? (nM - fm) : WGM;
        u.pm = fm + ((wgid % nig) % gsz); u.pn = (wgid % nig) / gsz; return true;
    }
    __device__ __forceinline__ void a_ready(const Unit&) const {}
    __device__ __forceinline__ void done(const Unit&) const {}
};

__device__ __forceinline__ unsigned cvt_pk_bf16(float lo, float hi) { unsigned r; asm volatile("v_cvt_pk_bf16_f32 %0, %1, %2" : "=v"(r) : "v"(lo), "v"(hi)); return r; }
typedef float f32x2 __attribute__((ext_vector_type(2)));
__device__ __forceinline__ f32x2 gelu_pk(f32x2 v) {
    const f32x2 av = __builtin_elementwise_abs(v), d = av * 0.2316418882f + 1.0f;
    f32x2 t; t.x = __builtin_amdgcn_rcpf(d.x); t.y = __builtin_amdgcn_rcpf(d.y);
    f32x2 q = t * 0.5307027145f + (-0.7265760135f); q = q * t + 0.7107068705f; q = q * t + (-0.142248368f); q = q * t + 0.127414796f; q = q * t;
    const f32x2 s = (v * v) * (-0.72134752044f);
    f32x2 e; e.x = __builtin_amdgcn_exp2f(s.x); e.y = __builtin_amdgcn_exp2f(s.y);
    const f32x2 m = v * (q * e), r = v - m;
    f32x2 o; o.x = v.x < 0.f ? m.x : r.x; o.y = v.y < 0.f ? m.y : r.y; return o;
}

template <int ACT  > struct EpiBf16 {
    static constexpr bool PERM = true, AFTER_DRAIN = false, MID = false; static_assert(ACT == 0 || ACT == 1, "EpiBf16: ACT is 0 (none) or 1 (gelu_pk)");
    bf16_t* O; int ldc; const float* bias; int split_cols; size_t split_stride; float scale0;
    __device__ __forceinline__ void operator()(const f32x4 (&acc)[2][2][4][2], const Unit& u, int wr, int wc, int fr, int fq) const {
        const int row0 = u.pm * BM + wr * 64 + fr; int colt = u.pn * BM; bf16_t* base = O;
        float sc = 1.f; if (split_cols) { const int t = colt / split_cols; base += (size_t)t * split_stride; colt -= t * split_cols; if (t == 0) sc = scale0; }
        const int col0 = colt + wc * 32 + 8 * fq, bcol0 = u.pn * BM + wc * 32 + 8 * fq;
        f32x4 bv[2][2];
#pragma unroll
        for (int bj = 0; bj < 2; ++bj)
#pragma unroll
            for (int n = 0; n < 2; ++n) bv[bj][n] = bias ? *(const f32x4*)(bias + bcol0 + bj * HALF + 4 * n) : (f32x4){0.f, 0.f, 0.f, 0.f};
#pragma unroll
        for (int ai = 0; ai < 2; ++ai)
#pragma unroll
            for (int m = 0; m < 4; ++m) { bf16_t* rowp = base + (size_t)(row0 + ai * HALF + m * 16) * ldc + col0;
#pragma unroll
                for (int bj = 0; bj < 2; ++bj) { f32x4 v0 = acc[ai][bj][m][0] + bv[bj][0], v1 = acc[ai][bj][m][1] + bv[bj][1];
                    if (ACT == 1) { f32x2 a = gelu_pk((f32x2){v0[0], v0[1]}), b = gelu_pk((f32x2){v0[2], v0[3]}), c = gelu_pk((f32x2){v1[0], v1[1]}), d = gelu_pk((f32x2){v1[2], v1[3]});
                        v0 = (f32x4){a.x, a.y, b.x, b.y}; v1 = (f32x4){c.x, c.y, d.x, d.y}; }
                    v0 = v0 * sc; v1 = v1 * sc; u32x4 w; w.x = cvt_pk_bf16(v0[0], v0[1]); w.y = cvt_pk_bf16(v0[2], v0[3]); w.z = cvt_pk_bf16(v1[0], v1[1]); w.w = cvt_pk_bf16(v1[2], v1[3]);
                    *(u32x4*)(rowp + bj * HALF) = w; } }
    }
};

__device__ __forceinline__ float blo(unsigned u) { return __uint_as_float(u << 16); }
__device__ __forceinline__ float bhi(unsigned u) { return __uint_as_float(u & 0xffff0000u); }
struct PairOrder {
    int nM, nN, nwg, G, c;
    __host__ __device__ void init(int M, int N, int G_, int c_) { nM = M / BM; nN = N / BM; nwg = nM * nN; G = G_; c = c_; }
    __host__ __device__ bool next(int i, Unit& u) const {
        const long L = (long)(i >> 1) * G + c; if (L >= nwg) return false;
        int wgid = (int)L; { const int q = nwg / NXCD, r = nwg % NXCD, xcd = wgid % NXCD, off = wgid / NXCD; wgid = (xcd < r ? xcd * (q + 1) : r * (q + 1) + (xcd - r) * q) + off; }
        const int nig = WGM * nN, gid = wgid / nig, fm = gid * WGM, gsz = (nM - fm) < WGM ? (nM - fm) : WGM;
        u.pm = fm + ((wgid % nig) % gsz); u.pn = 2 * ((wgid % nig) / gsz) + (i & 1); return true;
    }
    __device__ __forceinline__ void a_ready(const Unit&) const {}
    __device__ __forceinline__ void done(const Unit&) const {}
};
struct EpiMerge {
    static constexpr bool PERM = true, AFTER_DRAIN = false, MID = false;
    const bf16_t* G; int ldg, cgl, cga; float* tmp; int ldt; bf16_t* O; int ldc;
    __device__ __forceinline__ void operator()(f32x4 (&acc)[2][2][4][2], const Unit& u, int wr, int wc, int fr, int fq) const {
        const int sel = u.pn & 1; const int row0 = u.pm * BM + wr * 64 + fr, col0 = (u.pn >> 1) * BM + wc * 32 + 8 * fq; const int cg = sel ? cga : cgl;
        u32x4 L[2][2];
        { const bf16_t* rowp = G + (size_t)row0 * ldg + col0 + cg; L[0][0] = *(const u32x4*)(rowp); L[0][1] = *(const u32x4*)(rowp + HALF); }
#pragma unroll
        for (int idx = 0; idx < 8; ++idx) { const int ai = idx >> 2, m = idx & 3; const size_t r = (size_t)(row0 + ai * HALF + m * 16);
            if (idx < 7) { const int ai2 = (idx + 1) >> 2, m2 = (idx + 1) & 3; const bf16_t* rowp = G + (size_t)(row0 + ai2 * HALF + m2 * 16) * ldg + col0 + cg;
                L[(idx + 1) & 1][0] = *(const u32x4*)(rowp); L[(idx + 1) & 1][1] = *(const u32x4*)(rowp + HALF); }
#pragma unroll
            for (int bj = 0; bj < 2; ++bj) { u32x4 ga = L[idx & 1][bj];
                asm volatile("" : "+v"(ga));
                f32x4 o0, o1;
#pragma unroll
                for (int k = 0; k < 4; ++k) { const unsigned a = ga[k];
                    const float s0 = __builtin_amdgcn_rcpf(1.0f + __expf(-blo(a))), s1 = __builtin_amdgcn_rcpf(1.0f + __expf(-bhi(a)));
                    if (k < 2) { o0[2 * k] = acc[ai][bj][m][0][2 * k] * s0; o0[2 * k + 1] = acc[ai][bj][m][0][2 * k + 1] * s1; }
                    else { o1[2 * k - 4] = acc[ai][bj][m][1][2 * k - 4] * s0; o1[2 * k - 3] = acc[ai][bj][m][1][2 * k - 3] * s1; } }
                float* tp = tmp + r * ldt + col0 + bj * HALF;
                if (sel == 0) { *(f32x4*)tp = o0; *(f32x4*)(tp + 4) = o1; }
                else { const f32x4 t0 = *(const f32x4*)tp, t1 = *(const f32x4*)(tp + 4); o0 += t0; o1 += t1;
                    u32x4 w; w.x = cvt_pk_bf16(o0[0], o0[1]); w.y = cvt_pk_bf16(o0[2], o0[3]); w.z = cvt_pk_bf16(o1[0], o1[1]); w.w = cvt_pk_bf16(o1[2], o1[3]);
                    *(u32x4*)(O + r * ldc + col0 + bj * HALF) = w; } } }
    }
};
struct EpiResid {
    static constexpr bool PERM = false, AFTER_DRAIN = false, MID = false;
    const float* base; float* out; int ldc; float alpha;
    __device__ __forceinline__ void operator()(f32x4 (&acc)[2][2][4][2], const Unit& u, int wr, int wc, int fr, int fq) const {
        const int row0 = u.pm * BM + wr * 64 + fr, col0 = u.pn * BM + wc * 32 + 4 * fq;
#pragma unroll
        for (int ai = 0; ai < 2; ++ai)
#pragma unroll
            for (int m = 0; m < 4; ++m) { const size_t off = (size_t)(row0 + ai * HALF + m * 16) * ldc + col0;
#pragma unroll
                for (int bj = 0; bj < 2; ++bj)
#pragma unroll
                    for (int n = 0; n < 2; ++n) { const f32x4 bs = *(const f32x4*)(base + off + bj * HALF + n * 16); *(f32x4*)(out + off + bj * HALF + n * 16) = bs * alpha + acc[ai][bj][m][n]; } }
    }
};
__device__ __forceinline__ float dpp_prev1(float cur, float prev) {
    const int o = __builtin_amdgcn_update_dpp(0, __builtin_bit_cast(int, prev), 0x10F, 0xf, 0xf, true);
    return __builtin_bit_cast(float, __builtin_amdgcn_update_dpp(o, __builtin_bit_cast(int, cur), 0x111, 0xf, 0xf, false));
}
__device__ __forceinline__ float dpp_prev2(float cur, float prev) {
    const int o = __builtin_amdgcn_update_dpp(0, __builtin_bit_cast(int, prev), 0x10E, 0xf, 0xf, true);
    return __builtin_bit_cast(float, __builtin_amdgcn_update_dpp(o, __builtin_bit_cast(int, cur), 0x112, 0xf, 0xf, false));
}
struct EpiGeglu {
    static constexpr bool PERM = true, AFTER_DRAIN = false, MID = false;
    bf16_t* act; int ldact; const float* cw; const float* cb; float* head; float* tail; int nch;
    __device__ __forceinline__ void operator()(f32x4 (&acc)[2][2][4][2], const Unit& u, int wr, int wc, int fr, int fq) const {
        const int chb = u.pn * HALF + wc * 32 + 8 * fq;
        if (fr < 2 || fr >= 14) { const bool hd = fr < 2; float* eb = hd ? head : tail; const int er = hd ? fr : fr - 14;
#pragma unroll
            for (int ai = 0; ai < 2; ++ai) { float* ep = eb + ((size_t)(u.pm * 4 + ai * 2 + wr) * 2 + er) * (2 * nch) + u.pn * BM + wc * 32 + 8 * fq;
#pragma unroll
                for (int bj = 0; bj < 2; ++bj)
#pragma unroll
                    for (int n = 0; n < 2; ++n) { const f32x4 v0 = acc[ai][bj][0][n], v3 = acc[ai][bj][3][n]; f32x4 v; v[0] = hd ? v0[0] : v3[0]; v[1] = hd ? v0[1] : v3[1]; v[2] = hd ? v0[2] : v3[2]; v[3] = hd ? v0[3] : v3[3];
                        *(f32x4*)(ep + bj * HALF + 4 * n) = v; } } }
        __builtin_amdgcn_sched_barrier(0);
        f32x4 W[2][4];
        { const int cc = chb; W[0][0] = *(const f32x4*)(cw + cc); W[0][1] = *(const f32x4*)(cw + 2 * nch + cc); W[0][2] = *(const f32x4*)(cw + 4 * nch + cc); W[0][3] = *(const f32x4*)(cb + cc); }
#pragma unroll
        for (int idx = 0; idx < 4; ++idx) { const int n = idx >> 1, bj = idx & 1;
            if (idx < 3) { const int cc = ((idx + 1) & 1) * nch + chb + 4 * ((idx + 1) >> 1);
                W[(idx + 1) & 1][0] = *(const f32x4*)(cw + cc); W[(idx + 1) & 1][1] = *(const f32x4*)(cw + 2 * nch + cc); W[(idx + 1) & 1][2] = *(const f32x4*)(cw + 4 * nch + cc); W[(idx + 1) & 1][3] = *(const f32x4*)(cb + cc); }
            f32x4 w0 = W[idx & 1][0], w1 = W[idx & 1][1], w2 = W[idx & 1][2], bb = W[idx & 1][3];
            asm volatile("" : "+v"(w0), "+v"(w1), "+v"(w2), "+v"(bb));
#pragma unroll
            for (int ai = 0; ai < 2; ++ai) {
#pragma unroll
                for (int m = 3; m >= 0; --m) {
                    const f32x4 cur = acc[ai][bj][m][n], prv = acc[ai][bj][m > 0 ? m - 1 : 0][n]; f32x4 o;
#pragma unroll
                    for (int k = 0; k < 4; ++k) { const float p1 = dpp_prev1(cur[k], prv[k]), p2 = dpp_prev2(cur[k], prv[k]); o[k] = bb[k] + w0[k] * p2 + w1[k] * p1 + w2[k] * cur[k]; }
                    asm volatile("" : "+v"(o));
                    acc[ai][bj][m][n] = o;
                }
            }
            if (bj == 1) {
#pragma unroll
                for (int ai = 0; ai < 2; ++ai)
#pragma unroll
                    for (int m = 0; m < 4; ++m) { const f32x4 g = acc[ai][0][m][n], v = acc[ai][1][m][n]; f32x4 o;
#pragma unroll
                        for (int k = 0; k < 4; ++k) { const float x = g[k]; const float e = __builtin_amdgcn_exp2f(-x * (2.3022082f + 0.10294324f * x * x)); o[k] = x * v[k] * __builtin_amdgcn_rcpf(1.0f + e); }
                        asm volatile("" : "+v"(o));
                        acc[ai][0][m][n] = o; }
            }
        }
        const int row0 = u.pm * BM + wr * 64 + fr;
#pragma unroll
        for (int ai = 0; ai < 2; ++ai)
#pragma unroll
            for (int m = 0; m < 4; ++m) { const f32x4 a = acc[ai][0][m][0], b = acc[ai][0][m][1];
                u32x4 w; w.x = cvt_pk_bf16(a[0], a[1]); w.y = cvt_pk_bf16(a[2], a[3]); w.z = cvt_pk_bf16(b[0], b[1]); w.w = cvt_pk_bf16(b[2], b[3]);
                *(u32x4*)(act + (size_t)(row0 + ai * HALF + m * 16) * ldact + chb) = w; }
    }
};
template <class Epi, class Sched, bool ALIGN_EPI = false, bool SP2 = false>
__device__ __forceinline__ void gemm_phase(PG8_LAS unsigned char* lds, const Gemm g, const Sched& S, const Epi& E, int tid_in) {
    int tid_l = tid_in; asm volatile("" : "+v"(tid_l));
    const int tid = tid_l, wid = __builtin_amdgcn_readfirstlane(tid >> 6), lane = tid & 63, wr = wid >> 2, wc = wid & 3, fr = lane & 15, fq = lane >> 4;
    const int K = g.K, nt = K / BK;
    unsigned voffA[2], voffB[2];
#pragma unroll
    for (int i = 0; i < 2; ++i) { int R, C; stage_rc(tid * 16 + i * 8192, R, C); const int Rb = Epi::PERM ? ((R & ~31) + perm32(R & 31)) : R;
        voffA[i] = (unsigned)(R * g.lda + C) * 2u; voffB[i] = (unsigned)(Rb * K + C) * 2u; }
    const size_t kstep = (size_t)(BK * 2);
    const size_t hstep = (size_t)HALF * K * 2; const size_t hstepA = (size_t)HALF * g.lda * 2; const size_t tstepA = 2 * hstepA;
    const size_t tstep = 2 * hstep;
    const unsigned ldsw = (unsigned)wid * 1024u;
    const int aoff = lds_byte(wr * 64 + fr, fq * 8), boff = lds_byte(wc * 32 + fr, fq * 8);
#define PG8_SA(b, h) (((b) * 2 + (h)) * HTB)
#define PG8_SB(b, h) ((4 + (b) * 2 + (h)) * HTB)
#define PG8_STAGE(bufoff, gbase, voff) do { _Pragma("unroll") for (int _i = 0; _i < 2; ++_i) \
        __builtin_amdgcn_global_load_lds((const unsigned*)((const char*)(gbase) + (voff)[_i]), (PG8_LAS unsigned*)(lds + (bufoff) + ldsw + _i * 8192), 16, 0, 0); } while (0)
#define PG8_LDA(dst, b, h) do { _Pragma("unroll") for (int m = 0; m < 4; ++m) _Pragma("unroll") for (int k = 0; k < 2; ++k) dst[m][k] = *(const PG8_LAS bf16x8*)(lds + PG8_SA(b, h) + aoff + m * 2048 + k * 1024); } while (0)
#define PG8_LDB(dst, b, h) do { _Pragma("unroll") for (int n = 0; n < 2; ++n) _Pragma("unroll") for (int k = 0; k < 2; ++k) dst[n][k] = *(const PG8_LAS bf16x8*)(lds + PG8_SB(b, h) + boff + n * 2048 + k * 1024); } while (0)
#define PG8_MMA(ai, bj, At, Bt) do { __builtin_amdgcn_s_setprio(1); _Pragma("unroll") for (int m = 0; m < 4; ++m) _Pragma("unroll") for (int n = 0; n < 2; ++n) _Pragma("unroll") for (int k = 0; k < 2; ++k) \
        acc[ai][bj][m][n] = __builtin_amdgcn_mfma_f32_16x16x32_bf16(Bt[n][k], At[m][k], acc[ai][bj][m][n], 0, 0, 0); __builtin_amdgcn_s_setprio(0); } while (0)
#define PG8_WAIT_V(n) asm volatile("s_waitcnt vmcnt(" #n ")" ::: "memory")
#define PG8_WAIT_L(n) asm volatile("s_waitcnt lgkmcnt(" #n ")" ::: "memory")
#define PG8_BAR __builtin_amdgcn_s_barrier()
#define PG8_SCHED __builtin_amdgcn_sched_barrier(0)
    Unit cur, nxt; int ui = 0;
    if (!S.next(0, cur)) return;
    f32x4 acc[2][2][4][2];
#pragma unroll
    for (int a = 0; a < 2; ++a)
#pragma unroll
        for (int b = 0; b < 2; ++b)
#pragma unroll
            for (int m = 0; m < 4; ++m)
#pragma unroll
                for (int n = 0; n < 2; ++n) acc[a][b][m][n] = (f32x4){0.f, 0.f, 0.f, 0.f};
    bf16x8 At[4][2], B0[2][2], B1[2][2];
    const char* cA = (const char*)g.A + (size_t)cur.pm * tstepA + (size_t)(cur.pn & 1) * g.aalt; const char* cB = (const char*)g.Bt + (size_t)cur.pn * tstep;
    S.a_ready(cur);
    if constexpr (SP2) {
        PG8_STAGE(PG8_SB(0, 0), cB, voffB); PG8_STAGE(PG8_SB(0, 1), cB + hstep, voffB); PG8_STAGE(PG8_SA(0, 0), cA, voffA); PG8_STAGE(PG8_SA(0, 1), cA + hstepA, voffA);
        if (wr == 1) PG8_BAR;
        PG8_WAIT_V(2); PG8_BAR;
        PG8_STAGE(PG8_SB(1, 0), cB + kstep, voffB); PG8_STAGE(PG8_SA(1, 0), cA + kstep, voffA); PG8_STAGE(PG8_SB(1, 1), cB + hstep + kstep, voffB);
        PG8_WAIT_V(6); PG8_BAR;
    } else {
        PG8_STAGE(PG8_SB(0, 0), cB, voffB); PG8_STAGE(PG8_SA(0, 0), cA, voffA); PG8_STAGE(PG8_SB(0, 1), cB + hstep, voffB); PG8_STAGE(PG8_SA(0, 1), cA + hstepA, voffA);
        if (wr == 1) PG8_BAR;
        PG8_WAIT_V(4); PG8_BAR;
        PG8_STAGE(PG8_SB(1, 0), cB + kstep, voffB); PG8_STAGE(PG8_SA(1, 0), cA + kstep, voffA); PG8_STAGE(PG8_SB(1, 1), cB + hstep + kstep, voffB);
        PG8_WAIT_V(6); PG8_BAR;
    }
    for (;;) {
        const bool has_next = S.next(ui + 1, nxt);
        const char* nA = has_next ? (const char*)g.A + (size_t)nxt.pm * tstepA + (size_t)(nxt.pn & 1) * g.aalt : cA; const char* nB = has_next ? (const char*)g.Bt + (size_t)nxt.pn * tstep : cB;
        for (int t = 0; t < nt; t += 2) {
            const bool last = (t == nt - 2);
            const char* a1 = cA + (size_t)(t + 1) * kstep;
            const char* a2 = last ? nA : cA + (size_t)(t + 2) * kstep; const char* b2 = last ? nB : cB + (size_t)(t + 2) * kstep;
            const char* a3 = a2 + kstep; const char* b3 = b2 + kstep;
            if (last && has_next) S.a_ready(nxt);
            if constexpr (SP2) {
            PG8_LDB(B0, 0, 0); PG8_LDB(B1, 0, 1); PG8_SCHED; PG8_LDA(At, 0, 0); PG8_STAGE(PG8_SA(1, 1), a1 + hstepA, voffA);
            PG8_WAIT_V(8); PG8_WAIT_L(0); PG8_BAR; PG8_MMA(0, 0, At, B0); PG8_MMA(0, 1, At, B1); PG8_BAR; PG8_SCHED;
            PG8_LDA(At, 0, 1); PG8_STAGE(PG8_SB(0, 0), b2, voffB); PG8_STAGE(PG8_SB(0, 1), b2 + hstep, voffB); PG8_STAGE(PG8_SA(0, 0), a2, voffA);
            PG8_WAIT_V(8); PG8_WAIT_L(0); PG8_BAR; PG8_MMA(1, 0, At, B0); PG8_MMA(1, 1, At, B1); PG8_BAR; PG8_SCHED;
            PG8_LDB(B0, 1, 0); PG8_LDB(B1, 1, 1); PG8_SCHED; PG8_LDA(At, 1, 0); PG8_STAGE(PG8_SA(0, 1), a2 + hstepA, voffA);
            PG8_WAIT_V(8); PG8_WAIT_L(0); PG8_BAR; PG8_MMA(0, 0, At, B0); PG8_MMA(0, 1, At, B1); PG8_BAR; PG8_SCHED;
            PG8_LDA(At, 1, 1); PG8_STAGE(PG8_SB(1, 0), b3, voffB); PG8_STAGE(PG8_SB(1, 1), b3 + hstep, voffB); PG8_STAGE(PG8_SA(1, 0), a3, voffA);
            PG8_WAIT_V(8); PG8_WAIT_L(0); PG8_BAR; PG8_MMA(1, 0, At, B0); PG8_MMA(1, 1, At, B1); PG8_BAR; PG8_SCHED;
            } else {
            PG8_LDB(B0, 0, 0); PG8_SCHED; PG8_LDA(At, 0, 0); PG8_STAGE(PG8_SA(1, 1), a1 + hstepA, voffA);
            PG8_WAIT_L(8); PG8_BAR; PG8_WAIT_L(0); PG8_MMA(0, 0, At, B0); PG8_BAR; PG8_SCHED;
            PG8_LDB(B1, 0, 1); PG8_STAGE(PG8_SB(0, 0), b2, voffB);
            PG8_BAR; PG8_WAIT_L(0); PG8_MMA(0, 1, At, B1); PG8_BAR;
            PG8_LDA(At, 0, 1); PG8_STAGE(PG8_SA(0, 0), a2, voffA);
            PG8_BAR; PG8_WAIT_L(0); PG8_MMA(1, 0, At, B0); PG8_BAR; PG8_SCHED;
            PG8_STAGE(PG8_SB(0, 1), b2 + hstep, voffB);
            PG8_WAIT_V(6); PG8_BAR; PG8_MMA(1, 1, At, B1); PG8_BAR;
            PG8_LDB(B0, 1, 0); PG8_SCHED; PG8_LDA(At, 1, 0); PG8_STAGE(PG8_SA(0, 1), a2 + hstepA, voffA);
            PG8_WAIT_L(8); PG8_BAR; PG8_WAIT_L(0); PG8_MMA(0, 0, At, B0); PG8_BAR; PG8_SCHED;
            PG8_LDB(B1, 1, 1); PG8_STAGE(PG8_SB(1, 0), b3, voffB);
            PG8_BAR; PG8_WAIT_L(0); PG8_MMA(0, 1, At, B1); PG8_BAR;
            PG8_LDA(At, 1, 1); PG8_STAGE(PG8_SA(1, 0), a3, voffA);
            PG8_BAR; PG8_WAIT_L(0); PG8_MMA(1, 0, At, B0); PG8_BAR; PG8_SCHED;
            PG8_STAGE(PG8_SB(1, 1), b3 + hstep, voffB);
            PG8_WAIT_V(6); PG8_BAR; PG8_MMA(1, 1, At, B1); PG8_BAR;
            }
        }
        if constexpr (ALIGN_EPI) { if (wr == 0) PG8_BAR; }
        if constexpr (!Epi::AFTER_DRAIN) { E(acc, cur, wr, wc, fr, fq); S.done(cur); }
        if (!has_next) break;
#pragma unroll
        for (int a = 0; a < 2; ++a)
#pragma unroll
            for (int b = 0; b < 2; ++b)
#pragma unroll
                for (int m = 0; m < 4; ++m)
#pragma unroll
                    for (int n = 0; n < 2; ++n) acc[a][b][m][n] = (f32x4){0.f, 0.f, 0.f, 0.f};
        cur = nxt; cA = nA; cB = nB; ++ui;
        if constexpr (ALIGN_EPI) { if (wr == 1) PG8_BAR; }
    }
    PG8_WAIT_V(0);
    if constexpr (!ALIGN_EPI) { if (wr == 0) PG8_BAR; }
    PG8_BAR;
    if constexpr (Epi::AFTER_DRAIN) { E.fused(acc, cur, wr, wc, fr, fq, lds, wid, lane); S.done(cur); }
#undef PG8_SA
#undef PG8_SB
#undef PG8_STAGE
#undef PG8_LDA
#undef PG8_LDB
#undef PG8_MMA
#undef PG8_WAIT_V
#undef PG8_WAIT_L
#undef PG8_BAR
#undef PG8_SCHED
}
}
#define LAS __attribute__((address_space(3)))
typedef unsigned short bf16;
typedef unsigned v4u __attribute__((ext_vector_type(4)));
typedef unsigned v2u __attribute__((ext_vector_type(2)));
typedef float f32x4 __attribute__((ext_vector_type(4)));
typedef float f32x16 __attribute__((ext_vector_type(16)));
typedef short bf16x8 __attribute__((ext_vector_type(8)));
typedef short v4i16_t __attribute__((ext_vector_type(4)));
constexpr int NB = 8, S_ = 2048, D_ = 2048, T_ = NB * S_;
constexpr int NP = 11776;
constexpr int NIN = 11600;
constexpr int C_LX = 0, C_LG = 2048, C_Q = 4096, C_K = 6144, C_V = 6272, C_QI = 6400, C_KI = 7424, C_WI = 7488, C_GL = 7680, C_GA = 9728;
constexpr int FF = 6144, FF2 = 12288;
constexpr float LN_EPS = 1e-5f;
constexpr float ALPHA = 1.189207115f;
constexpr size_t MiB = 1u << 20;
constexpr size_t WS_WINT = 0, WS_XB = 48 * MiB;
constexpr size_t WS_WLA = 0, WS_WOUT = 16 * MiB, WS_WUP = 24 * MiB, WS_WDN = 72 * MiB;
constexpr size_t WS_PROJ = 112 * MiB;
constexpr size_t WS_KIN = 480 * MiB;
constexpr size_t WS_H1B = 112 * MiB, WS_ACT = 176 * MiB, WS_HEAD = 368 * MiB, WS_TAIL = 400 * MiB;
constexpr size_t WS_CTL = 482 * MiB;
constexpr size_t WS_KV = 484 * MiB;
constexpr size_t WS_END = 492 * MiB;
constexpr int LDS_BYTES = 147456;

__device__ __forceinline__ float bf_lo(unsigned u) { return __uint_as_float(u << 16); }
__device__ __forceinline__ float bf_hi(unsigned u) { return __uint_as_float(u & 0xffff0000u); }
__device__ __forceinline__ float bf1(bf16 h) { return __uint_as_float(((unsigned)h) << 16); }
__device__ __forceinline__ unsigned f2bf(float f) { unsigned u = __float_as_uint(f); return (u + 0x7fffu + ((u >> 16) & 1u)) >> 16; }
__device__ __forceinline__ unsigned pk2(float lo, float hi) { return pg8::cvt_pk_bf16(lo, hi); }
__device__ __forceinline__ float sigmoidf_(float x) { return __builtin_amdgcn_rcpf(1.0f + __expf(-x)); }
__device__ __forceinline__ float gelu_t(float x) { const float e = __builtin_amdgcn_exp2f(-x * (2.3022082f + 0.10294324f * x * x)); return x * __builtin_amdgcn_rcpf(1.0f + e); }
__device__ __forceinline__ float wave_sum(float v) {
#pragma unroll
    for (int o = 1; o < 64; o <<= 1) v += __shfl_xor(v, o);
    return v;
}
#define XB_TMO      128
#define XB_XCNT(j)  (256  + 64 * (j))
#define XB_XSUB(j)  (1280 + 64 * (j))
#define XB_XGEN(j)  (2304 + 64 * (j))
#define XB_TOP      3328
#define XB_TOPGEN   3392
#define XCD_BAR_WORDS 3456
#define XB_SPIN_CAP (1u << 18)

__device__ __forceinline__ unsigned xb_ld(unsigned* p)              { return __hip_atomic_load(p, __ATOMIC_RELAXED, __HIP_MEMORY_SCOPE_AGENT); }
__device__ __forceinline__ unsigned xb_add(unsigned* p, unsigned v) { return __hip_atomic_fetch_add(p, v, __ATOMIC_RELAXED, __HIP_MEMORY_SCOPE_AGENT); }
__device__ __forceinline__ unsigned xb_xcc_id() { return (unsigned)__builtin_amdgcn_s_getreg((3 << 11) | 20) & 0xFu; }
#define XB_SPIN(cond, bar) do { unsigned _sp = 0; while (cond) { __builtin_amdgcn_s_sleep(1); \
    if ((++_sp & 255u) == 0u) { if (xb_ld(&(bar)[XB_TMO])) break; if (_sp > XB_SPIN_CAP) { atomicAdd(&(bar)[XB_TMO], 1u); break; } } } } while (0)

struct XcdBarrier {
    unsigned* bar; unsigned x;
    volatile LAS unsigned* st;
};

__device__ __forceinline__ XcdBarrier xcd_barrier_post(unsigned* bar, volatile LAS unsigned* st, int tid) {
    XcdBarrier b; b.bar = bar; b.x = xb_xcc_id(); b.st = st;
    if (tid == 0) (void)xb_add(&bar[XB_XCNT(b.x)], 1u);
    return b;
}
__device__ __forceinline__ void xcd_barrier_complete(unsigned* bar, unsigned x, unsigned& nloc, unsigned& nx) {
    const unsigned G = gridDim.x * gridDim.y * gridDim.z;
    unsigned sum, cnt, mine, sp = 0u;
    for (;;) {
        sum = 0u; cnt = 0u; mine = 0u;
#pragma unroll
        for (unsigned j = 0; j < 16; ++j) { const unsigned c = xb_ld(&bar[XB_XCNT(j)]); sum += c; cnt += (c > 0u) ? 1u : 0u; mine = (j == x) ? c : mine; }
        if (sum == G) break;
        __builtin_amdgcn_s_sleep(1);
        if ((++sp & 255u) == 0u) { if (xb_ld(&bar[XB_TMO])) break; if (sp > XB_SPIN_CAP) { atomicAdd(&bar[XB_TMO], 1u); break; } }
    }
    nloc = mine > 0u ? mine : 1u; nx = cnt > 0u ? cnt : 1u;
}

__device__ __forceinline__ void xcd_barrier(const XcdBarrier& b, int tid) {
    asm volatile("s_waitcnt vmcnt(0)" ::: "memory");
    __syncthreads();
    if (tid == 0) {
        unsigned* bar = b.bar;
        __builtin_amdgcn_s_waitcnt(0);
        unsigned nloc = b.st[0], nx = b.st[1];
        if (nloc == 0u) { xcd_barrier_complete(bar, b.x, nloc, nx); b.st[0] = nloc; b.st[1] = nx; }
        const unsigned old = xb_add(&bar[XB_XSUB(b.x)], 1u);
        const unsigned gen = old / nloc;
        if (old + 1u == (gen + 1u) * nloc) {
            __builtin_amdgcn_fence(__ATOMIC_RELEASE, "agent");
            asm volatile("s_waitcnt vmcnt(0)" ::: "memory");
            const unsigned og = xb_add(&bar[XB_TOP], 1u);
            const unsigned tg = og / nx;
            if (og + 1u == (tg + 1u) * nx) xb_add(&bar[XB_TOPGEN], 1u);
            else XB_SPIN(xb_ld(&bar[XB_TOPGEN]) == tg, bar);
            __builtin_amdgcn_fence(__ATOMIC_ACQUIRE, "agent");
            xb_add(&bar[XB_XGEN(b.x)], 1u);
            asm volatile("s_waitcnt vmcnt(0)" ::: "memory");
        } else {
            XB_SPIN(xb_ld(&bar[XB_XGEN(b.x)]) == gen, bar);
            __builtin_amdgcn_fence(__ATOMIC_ACQUIRE, "agent");
            asm volatile("s_waitcnt vmcnt(0)" ::: "memory");
        }
    }
    __syncthreads();
}
struct P {
    const float *x, *w_in, *lru_conv_w, *lru_conv_b, *ga_w, *ga_b, *gx_w, *gx_b, *lam, *kn_g, *kn_b, *rel_bias, *w_pl, *w_pa, *w_out, *ln1_g, *ln1_b, *w_up, *fc_w, *fc_b, *w_dn, *ln2_g, *ln2_b;
    float* out; unsigned char* ws;
};
template <class MapN>
__device__ __forceinline__ void transpose_item(const float* W, int N, bf16* WT, int ldk, int koff, LAS float* scr, int kb, int nb, int lane, MapN map) {
    const int k0 = 64 * kb, n0 = 32 * nb; const int c4 = lane & 7, nn = n0 + 4 * c4;
    f32x4 v[8];
#pragma unroll
    for (int i = 0; i < 8; ++i) { const int kk = 8 * i + (lane >> 3); v[i] = nn < N ? *(const f32x4*)(W + (size_t)(k0 + kk) * N + nn) : (f32x4){0.f, 0.f, 0.f, 0.f}; }
#pragma unroll
    for (int i = 0; i < 8; ++i) { const int kk = 8 * i + (lane >> 3); LAS float* d = scr + kk * 33 + 4 * c4; d[0] = v[i][0]; d[1] = v[i][1]; d[2] = v[i][2]; d[3] = v[i][3]; }
    asm volatile("s_waitcnt lgkmcnt(0)" ::: "memory");
    const int c = lane & 7;
#pragma unroll
    for (int j = 0; j < 4; ++j) { const int n = (lane >> 3) + 8 * j; const LAS float* s = scr + (8 * c) * 33 + n;
        v4u o; o.x = pk2(s[0 * 33], s[1 * 33]); o.y = pk2(s[2 * 33], s[3 * 33]); o.z = pk2(s[4 * 33], s[5 * 33]); o.w = pk2(s[6 * 33], s[7 * 33]);
        if (n0 + n < N) *(v4u*)(WT + (size_t)map(n0 + n) * ldk + koff + k0 + 8 * c) = o; }
    asm volatile("s_waitcnt lgkmcnt(0)" ::: "memory");
}
struct MapId { __device__ __forceinline__ int operator()(int n) const { return n; } };
struct MapPair { int sel; __device__ __forceinline__ int operator()(int n) const { return 512 * (n >> 8) + 256 * sel + (n & 255); } };
struct MapIn { __device__ __forceinline__ int operator()(int n) const { return n < 7504 ? n : n + 176; } };
struct MapUp { __device__ __forceinline__ int operator()(int n) const { const int v = n >= FF ? 1 : 0, j = n - v * FF; return 256 * (j >> 7) + 128 * v + (j & 127); } };

__device__ __forceinline__ void phase0(const P& p, LAS unsigned char* lds, int gw, int NGW, int lane, int wave) {
    LAS float* scr = (LAS float*)(lds + wave * 16384);
    bf16* winT = (bf16*)(p.ws + WS_WINT);
    constexpr int NBLK = (NIN + 31) / 32;
    for (int it = gw; it < 32 * NBLK; it += NGW) transpose_item(p.w_in, NIN, winT, D_, 0, scr, it / NBLK, it % NBLK, lane, MapIn());
    for (int i = gw * 64 + lane; i < 176 * D_ / 8; i += NGW * 64) *(v4u*)(winT + (size_t)7504 * D_ + (size_t)i * 8) = (v4u){0u, 0u, 0u, 0u};
    bf16* xb = (bf16*)(p.ws + WS_XB);
    {   const size_t NT = (size_t)NGW * 64, n8 = (size_t)T_ * D_ / 8;
        for (size_t i = (size_t)gw * 64 + lane; i < n8; i += 4 * NT) {
            f32x4 a[4], b[4];
#pragma unroll
            for (int q = 0; q < 4; ++q) { const size_t j = i + q * NT; if (j < n8) { a[q] = *(const f32x4*)(p.x + j * 8); b[q] = *(const f32x4*)(p.x + j * 8 + 4); } }
#pragma unroll
            for (int q = 0; q < 4; ++q) { const size_t j = i + q * NT; if (j < n8) { v4u o; o.x = pk2(a[q][0], a[q][1]); o.y = pk2(a[q][2], a[q][3]); o.z = pk2(b[q][0], b[q][1]); o.w = pk2(b[q][2], b[q][3]); *(v4u*)(xb + j * 8) = o; } }
        } }
}
__device__ __forceinline__ void phase15(const P& p, LAS unsigned char* lds, int gw, int NGW, int lane, int wave) {
    LAS float* scr = (LAS float*)(lds + wave * 16384);
    bf16* wla = (bf16*)(p.ws + WS_WLA); bf16* wout = (bf16*)(p.ws + WS_WOUT); bf16* wup = (bf16*)(p.ws + WS_WUP); bf16* wdn = (bf16*)(p.ws + WS_WDN);
    constexpr int I_SQ = 32 * 64, I_UP = 32 * (FF2 / 32), I_DN = (FF / 64) * 64;
    constexpr int NIT = 3 * I_SQ + I_UP + I_DN;
    for (int it = gw; it < NIT; it += NGW) {
        int r = it;
        if (r < I_SQ) { transpose_item(p.w_pl, D_, wla, D_, 0, scr, r / 64, r % 64, lane, MapPair{0}); continue; } r -= I_SQ;
        if (r < I_SQ) { transpose_item(p.w_pa, D_, wla, D_, 0, scr, r / 64, r % 64, lane, MapPair{1}); continue; } r -= I_SQ;
        if (r < I_SQ) { transpose_item(p.w_out, D_, wout, D_, 0, scr, r / 64, r % 64, lane, MapId()); continue; } r -= I_SQ;
        if (r < I_UP) { transpose_item(p.w_up, FF2, wup, D_, 0, scr, r / (FF2 / 32), r % (FF2 / 32), lane, MapUp()); continue; } r -= I_UP;
        transpose_item(p.w_dn, D_, wdn, FF, 0, scr, r / 64, r % 64, lane, MapId());
    }
    const bf16* proj = (const bf16*)(p.ws + WS_PROJ); bf16* kin = (bf16*)(p.ws + WS_KIN);
    bf16* kv = (bf16*)(p.ws + WS_KV);
    const float g = p.kn_g[lane], bta = p.kn_b[lane];
    for (int t = gw; t < T_; t += NGW) {
        if (lane < 32) *(v4u*)(kv + (size_t)t * 256 + 8 * lane) = *(const v4u*)(proj + (size_t)t * NP + C_K + 8 * lane);
        const float v = bf1(proj[(size_t)t * NP + C_KI + lane]);
        const float mu = wave_sum(v) * (1.f / 64.f); const float d = v - mu; const float var = wave_sum(d * d) * (1.f / 64.f);
        kin[(size_t)t * 64 + lane] = (bf16)f2bf(d * __builtin_amdgcn_rsqf(var + LN_EPS) * g + bta);
    }
}
__device__ __forceinline__ void ln_rows(float* io, bf16* ob, const float* gam, const float* bet, int gw, int NGW, int lane) {
    for (int t = gw; t < T_; t += NGW) {
        f32x4* r = (f32x4*)(io + (size_t)t * D_) + lane; f32x4 v[8]; float s = 0.f;
#pragma unroll
        for (int j = 0; j < 8; ++j) { v[j] = r[64 * j]; s += (v[j][0] + v[j][1]) + (v[j][2] + v[j][3]); }
        const float mu = wave_sum(s) * (1.f / D_); float q = 0.f;
#pragma unroll
        for (int j = 0; j < 8; ++j) { v[j] = v[j] - mu; q += (v[j][0] * v[j][0] + v[j][1] * v[j][1]) + (v[j][2] * v[j][2] + v[j][3] * v[j][3]); }
        const float rstd = 1.0f / sqrtf(wave_sum(q) * (1.f / D_) + LN_EPS);
#pragma unroll
        for (int j = 0; j < 8; ++j) { const f32x4 g = *((const f32x4*)gam + lane + 64 * j), b = *((const f32x4*)bet + lane + 64 * j); const f32x4 o = v[j] * rstd * g + b; r[64 * j] = o;
            if (ob) { v2u w; w.x = pk2(o[0], o[1]); w.y = pk2(o[2], o[3]); *(v2u*)(ob + (size_t)t * D_ + 4 * (lane + 64 * j)) = w; } }
    }
}
__device__ __forceinline__ void ffn_fixup(const P& p, int gtid, int NT) {
    const float* head = (const float*)(p.ws + WS_HEAD); const float* tail = (const float*)(p.ws + WS_TAIL); bf16* act = (bf16*)(p.ws + WS_ACT);
    for (int i = gtid; i < (T_ / 64) * 2 * FF; i += NT) {
        const int j = i % FF, gr = i / FF, r = gr & 1, G = gr >> 1; const int tc = 256 * (j >> 7) + (j & 127);
        const bool first = (G & 31) == 0;
        float o2[2];
#pragma unroll
        for (int v = 0; v < 2; ++v) { const int c = tc + 128 * v, ch = j + v * FF;
            const float h0 = head[((size_t)G * 2 + 0) * FF2 + c], h1 = head[((size_t)G * 2 + 1) * FF2 + c];
            const float t0 = first ? 0.f : tail[((size_t)(G - 1) * 2 + 0) * FF2 + c], t1 = first ? 0.f : tail[((size_t)(G - 1) * 2 + 1) * FF2 + c];
            const float x0 = r ? h1 : h0, x1 = r ? h0 : t1, x2 = r ? t1 : t0;
            o2[v] = p.fc_b[ch] + p.fc_w[ch] * x2 + p.fc_w[FF2 + ch] * x1 + p.fc_w[2 * FF2 + ch] * x0; }
        act[(size_t)(G * 64 + r) * FF + j] = (bf16)f2bf(gelu_t(o2[0]) * o2[1]);
    }
}
template <bool STORE>
__device__ __forceinline__ void lru_unit(const P& p, LAS unsigned char* lds, int u, int tid, int lane, int wave) {
    constexpr int XA_P = 272;
    constexpr int GT_P = 132;
    LAS unsigned char* XA = lds;
    LAS float* XC = (LAS float*)(lds + 34816);
    LAS float* GT = (LAS float*)(lds + 67584);
    LAS float* SEGA = (LAS float*)(lds + 135168);
    LAS float* SEGH = SEGA + 512;
    LAS float* CAR = SEGH + 512;
    const int b = u >> 5, n = (u & 31) >> 1, half = u & 1, cin0 = 128 * n, cout0 = cin0 + 64 * half;
    bf16* proj = (bf16*)(p.ws + WS_PROJ);
    const int fr = lane & 15, fq = lane >> 4;
    bf16x8 Bf[4];
    { const float* Wg = (wave < 4 ? p.ga_w : p.gx_w) + (size_t)n * 128 * 128 + 64 * half + 16 * (wave & 3) + fr;
#pragma unroll
      for (int s = 0; s < 4; ++s) { unsigned w[4];
#pragma unroll
          for (int jj = 0; jj < 4; ++jj) w[jj] = pk2(Wg[(size_t)(32 * s + 8 * fq + 2 * jj) * 128], Wg[(size_t)(32 * s + 8 * fq + 2 * jj + 1) * 128]);
          Bf[s] = __builtin_bit_cast(bf16x8, (v4u){w[0], w[1], w[2], w[3]}); } }
    const int c = tid & 63, seg = tid >> 6;
    const float ba = p.ga_b[cout0 + c], bx = p.gx_b[cout0 + c];
    const float sp8 = -8.0f * log1pf(__expf(-p.lam[cout0 + c]));
    if (tid < 128) CAR[tid] = 0.f;
    const int cg8 = tid & 15, tg = tid >> 4;
    for (int ch = 0; ch < S_ / 128; ++ch) {
        const int tc0 = ch * 128;
        {
            float wj[4][8], bb[8];
#pragma unroll
            for (int j = 0; j < 4; ++j) { const f32x4 a = *(const f32x4*)(p.lru_conv_w + j * D_ + cin0 + 8 * cg8), d = *(const f32x4*)(p.lru_conv_w + j * D_ + cin0 + 8 * cg8 + 4);
#pragma unroll
                for (int e = 0; e < 4; ++e) { wj[j][e] = a[e]; wj[j][4 + e] = d[e]; } }
            { const f32x4 a = *(const f32x4*)(p.lru_conv_b + cin0 + 8 * cg8), d = *(const f32x4*)(p.lru_conv_b + cin0 + 8 * cg8 + 4);
#pragma unroll
              for (int e = 0; e < 4; ++e) { bb[e] = a[e]; bb[4 + e] = d[e]; } }
            float xr[7][8];
#pragma unroll
            for (int r = 0; r < 7; ++r) { const int t = tc0 + 4 * tg - 3 + r;
                v4u raw = (v4u){0u, 0u, 0u, 0u};
                if (t >= 0) raw = *(const v4u*)(proj + (size_t)(b * S_ + t) * NP + C_LX + cin0 + 8 * cg8);
#pragma unroll
                for (int k = 0; k < 4; ++k) { xr[r][2 * k] = bf_lo(raw[k]); xr[r][2 * k + 1] = bf_hi(raw[k]); } }
#pragma unroll
            for (int q = 0; q < 4; ++q) { float o[8];
#pragma unroll
                for (int e = 0; e < 8; ++e) o[e] = bb[e] + wj[0][e] * xr[q][e] + wj[1][e] * xr[q + 1][e] + wj[2][e] * xr[q + 2][e] + wj[3][e] * xr[q + 3][e];
                const int tok = 4 * tg + q;
                v4u w; w.x = pk2(o[0], o[1]); w.y = pk2(o[2], o[3]); w.z = pk2(o[4], o[5]); w.w = pk2(o[6], o[7]);
                *(LAS v4u*)(XA + tok * XA_P + cg8 * 16) = w;
                if ((cg8 >> 3) == half) { LAS float* xc = XC + tok * 64 + 8 * (cg8 & 7); *(LAS f32x4*)xc = (f32x4){o[0], o[1], o[2], o[3]}; *(LAS f32x4*)(xc + 4) = (f32x4){o[4], o[5], o[6], o[7]}; } }
        }
        bf16 lg[16];
#pragma unroll
        for (int k = 0; k < 16; ++k) lg[k] = proj[(size_t)(b * S_ + tc0 + 16 * seg + k) * NP + C_LG + cout0 + c];
        __syncthreads();
#pragma unroll
        for (int rt = 0; rt < 8; ++rt) { f32x4 acc = (f32x4){0.f, 0.f, 0.f, 0.f};
#pragma unroll
            for (int s = 0; s < 4; ++s) { const bf16x8 a = *(const LAS bf16x8*)(XA + (16 * rt + fr) * XA_P + (32 * s + 8 * fq) * 2); acc = __builtin_amdgcn_mfma_f32_16x16x32_bf16(a, Bf[s], acc, 0, 0, 0); }
#pragma unroll
            for (int i = 0; i < 4; ++i) GT[(16 * rt + 4 * fq + i) * GT_P + 16 * wave + fr] = acc[i]; }
        __syncthreads();
        float av[16], uv[16]; float hl = 0.f, Al = 1.f;
#pragma unroll
        for (int k = 0; k < 16; ++k) { const int tok = 16 * seg + k;
            const float r = sigmoidf_(GT[tok * GT_P + c] + ba), ii = sigmoidf_(GT[tok * GT_P + 64 + c] + bx);
            const float a = __expf(sp8 * r); float mult = sqrtf(fmaxf(1.0f - a * a, 0.f)); if (tc0 + tok == 0) mult = 1.0f;
            const float uu = mult * ii * XC[tok * 64 + c];
            av[k] = a; uv[k] = uu; hl = a * hl + uu; Al *= a; }
        SEGA[seg * 64 + c] = Al; SEGH[seg * 64 + c] = hl;
        __syncthreads();
        float cin = CAR[(ch & 1) * 64 + c];
        for (int s2 = 0; s2 < seg; ++s2) cin = SEGA[s2 * 64 + c] * cin + SEGH[s2 * 64 + c];
        if (seg == 7) CAR[((ch + 1) & 1) * 64 + c] = Al * cin + hl;
        float h = cin;
#pragma unroll
        for (int k = 0; k < 16; ++k) { h = av[k] * h + uv[k];
            const bf16 yv = (bf16)f2bf(gelu_t(bf1(lg[k])) * h); if (STORE || yv == 0x1234) proj[(size_t)(b * S_ + tc0 + 16 * seg + k) * NP + C_LG + cout0 + c] = yv; }
    }
    __syncthreads();
}
constexpr int A_VT = 0, VT_P = 288, A_LIST = 73728, A_BUCK = 81920, A_BIAS = 83968;
__device__ __forceinline__ unsigned offb(unsigned row, unsigned ch) { return 256u * row + 16u * (ch ^ (((row & 3) << 2) | ((row >> 2) & 3))); }
__device__ __forceinline__ void dsa_tables(const P& p, LAS unsigned char* lds, int tid) {
    LAS unsigned char* BUCK = lds + A_BUCK; LAS float* BIAS = (LAS float*)(lds + A_BIAS);
    for (int rel = tid; rel < S_; rel += 512) { int bk;
        if (rel < 16) bk = rel; else { const float nf = (float)rel; int lg = 16 + (int)(logf(nf / 16.0f) / 2.0794415416798357f * 16.0f); bk = lg < 31 ? lg : 31; }
        BUCK[rel] = (unsigned char)bk; }
    BIAS[tid] = p.rel_bias[tid];
    __syncthreads();
}
template <bool STORE, bool ATT = true>
__device__ __forceinline__ void dsa_unit(const P& p, LAS unsigned char* lds, int b, int tg, int lane, int wave) {
    bf16* proj = (bf16*)(p.ws + WS_PROJ); const bf16* kin = (const bf16*)(p.ws + WS_KIN); const bf16* kv = (const bf16*)(p.ws + WS_KV);
    LAS unsigned short* LIST = (LAS unsigned short*)(lds + A_LIST) + wave * 512;
    LAS unsigned char* VT = lds + A_VT + wave * (32 * VT_P);
    const LAS unsigned char* BUCK = lds + A_BUCK; const LAS float* BIAS = (const LAS float*)(lds + A_BIAS);
    const int t0 = 16 * tg + 2 * wave;
    const size_t rowb = (size_t)b * S_;
    unsigned scr[64];
#ifdef DSA_NOIDX
#pragma unroll
    for (int j = 0; j < 64; ++j) scr[j] = lane * j;
#else
    {
        const int r = lane & 31, kh = lane >> 5;
        const int atok = t0 + ((r >> 2) & 1), ahead = 4 * (r >> 3) + (r & 3);
        bf16x8 Aq[4];
        { const bf16* qp = proj + (rowb + atok) * NP + C_QI + ahead * 64 + 32 * kh;
#pragma unroll
          for (int s = 0; s < 4; ++s) Aq[s] = *(const bf16x8*)(qp + 8 * s); }
        float wv[16];
        { const bf16* wp = proj + (rowb + t0 + kh) * NP + C_WI; const v4u w0 = *(const v4u*)wp, w1 = *(const v4u*)(wp + 8);
#pragma unroll
          for (int k = 0; k < 4; ++k) { wv[2 * k] = bf_lo(w0[k]) * 0.03125f; wv[2 * k + 1] = bf_hi(w0[k]) * 0.03125f; wv[8 + 2 * k] = bf_lo(w1[k]) * 0.03125f; wv[9 + 2 * k] = bf_hi(w1[k]) * 0.03125f; } }
        const int mytok = t0 + kh;
        const int ngrp = (t0 + 1) / 256 + 1;
        constexpr int KT_P = 144, KT_B = 256 * KT_P;
        const int tid = wave * 64 + lane;
        __syncthreads();
        v4u kst[4];
        { int t2 = tid; asm volatile("" : "+v"(t2)); const bf16* gp = kin + rowb * 64 + (size_t)t2 * 8;
#pragma unroll
          for (int i = 0; i < 4; ++i) kst[i] = *(const v4u*)(gp + i * 4096);
#pragma unroll
          for (int i = 0; i < 4; ++i) { const int id = tid + 512 * i; *(LAS v4u*)(lds + (id >> 3) * KT_P + (id & 7) * 16) = kst[i]; } }
        __syncthreads();
#pragma unroll
        for (int g8 = 0; g8 < 8; ++g8) {
            if (g8 < ngrp) {
                const bool more = g8 + 1 < ngrp;
                if (more) { int t2 = tid; asm volatile("" : "+v"(t2)); const bf16* gp = kin + (rowb + 256 * (g8 + 1)) * 64 + (size_t)t2 * 8;
#pragma unroll
                    for (int i = 0; i < 4; ++i) kst[i] = *(const v4u*)(gp + i * 4096); }
                const LAS unsigned char* kt = lds + (g8 & 1) * KT_B + r * KT_P + 64 * kh;
#pragma unroll
                for (int j = 0; j < 8; ++j) { const int blk = g8 * 8 + j, key = 32 * blk + r;
                    bf16x8 kb[4];
#pragma unroll
                    for (int s = 0; s < 4; ++s) kb[s] = *(const LAS bf16x8*)(kt + j * (32 * KT_P) + 16 * s);
                    f32x16 acc;
#pragma unroll
                    for (int e = 0; e < 16; ++e) acc[e] = 0.f;
#pragma unroll
                    for (int s = 0; s < 4; ++s) acc = __builtin_amdgcn_mfma_f32_32x32x16_bf16(Aq[s], kb[s], acc, 0, 0, 0);
                    float sc = 0.f;
#pragma unroll
                    for (int e = 0; e < 16; ++e) sc += wv[e] * fmaxf(acc[e], 0.f);
                    const unsigned ub = __float_as_uint(sc); const unsigned mono = ub ^ ((ub >> 31) ? 0xFFFFFFFFu : 0x80000000u);
                    unsigned sv = key <= mytok ? mono : 0u; asm volatile("" : "+v"(sv)); scr[blk] = sv; if (j & 1) __builtin_amdgcn_sched_barrier(0); }
                if (more) {
#pragma unroll
                    for (int i = 0; i < 4; ++i) { const int id = tid + 512 * i; *(LAS v4u*)(lds + ((g8 + 1) & 1) * KT_B + (id >> 3) * KT_P + (id & 7) * 16) = kst[i]; } }
                __syncthreads();
            } else {
#pragma unroll
                for (int j = 0; j < 8; ++j) scr[g8 * 8 + j] = 0u;
            }
        }
    }
#endif
    {
        unsigned T = 0u; bool finlo = false, finhi = false;
        for (int bit = 31; bit >= 0; --bit) {
            const unsigned cand = T | (1u << bit); int cnt = 0;
#pragma unroll
            for (int j = 0; j < 64; ++j) cnt += (scr[j] >= cand) ? 1 : 0;
            cnt += __builtin_amdgcn_update_dpp(0, cnt, 0x111, 0xf, 0xf, true); cnt += __builtin_amdgcn_update_dpp(0, cnt, 0x112, 0xf, 0xf, true);
            cnt += __builtin_amdgcn_update_dpp(0, cnt, 0x114, 0xf, 0xf, true); cnt += __builtin_amdgcn_update_dpp(0, cnt, 0x118, 0xf, 0xf, true);
            cnt += __builtin_amdgcn_update_dpp(0, cnt, 0x142, 0xa, 0xf, false);
            const int clo = __builtin_amdgcn_readlane(cnt, 31), chi = __builtin_amdgcn_readlane(cnt, 63);
            const bool ulo = !finlo && clo >= 256, uhi = !finhi && chi >= 256;
            if (lane < 32 ? ulo : uhi) T = cand;
            finlo |= (clo == 256); finhi |= (chi == 256);
            if (finlo && finhi) break;
        }
        const unsigned Tm = T > 1u ? T : 1u;
        LAS unsigned short* mylist = LIST + (lane >> 5) * 256; int blo = 0, bhi = 0;
#pragma unroll
        for (int j = 0; j < 64; ++j) { const bool s = scr[j] >= Tm; const unsigned long long m = __ballot(s); const unsigned mlo = (unsigned)m, mhi = (unsigned)(m >> 32);
            const unsigned mm = lane < 32 ? mlo : mhi; const int pos = (lane < 32 ? blo : bhi) + __popc(mm & ((1u << (lane & 31)) - 1u));
            if (s && pos < 256) mylist[pos] = (unsigned short)(32 * j + (lane & 31));
            blo += __popc(mlo); bhi += __popc(mhi); }
        for (int q = (lane < 32 ? blo : bhi) + (lane & 31); q < 256; q += 32) mylist[q] = 0xFFFFu;
    }
    asm volatile("s_waitcnt lgkmcnt(0)" ::: "memory");
    if constexpr (ATT) {
    int lane_a = lane; asm volatile("" : "+v"(lane_a));
    const int fr = lane_a & 15, fq = lane_a >> 4;
#pragma unroll 1
    for (int tt = 0; tt < 2; ++tt) {
        const int tok = t0 + tt; const LAS unsigned short* list = LIST + tt * 256;
        bf16x8 Qf[4];
        { const bf16* qp = proj + (rowb + tok) * NP + C_Q + fr * 128 + 32 * fq;
#pragma unroll
          for (int s = 0; s < 4; ++s) Qf[s] = *(const bf16x8*)(qp + 8 * s); }
        f32x4 sr[16];
#pragma unroll
        for (int gq = 0; gq < 4; ++gq) {
            bf16x8 kf[4][4];
#pragma unroll
            for (int g4 = 0; g4 < 4; ++g4) { const unsigned id = list[16 * (4 * gq + g4) + fr]; const unsigned key = id == 0xFFFFu ? 0u : id;
                const bf16* kp = kv + (rowb + key) * 256 + 32 * fq;
#pragma unroll
                for (int s = 0; s < 4; ++s) kf[g4][s] = *(const bf16x8*)(kp + 8 * s); }
#pragma unroll
            for (int g4 = 0; g4 < 4; ++g4) {
#pragma unroll
                for (int s = 0; s < 4; ++s) asm volatile("" : "+v"(kf[g4][s]));
                f32x4 a = (f32x4){0.f, 0.f, 0.f, 0.f};
#pragma unroll
                for (int s = 0; s < 4; ++s) a = __builtin_amdgcn_mfma_f32_16x16x32_bf16(kf[g4][s], Qf[s], a, 0, 0, 0);
                asm volatile("" : "+v"(a)); sr[4 * gq + g4] = a; }
        }
        float mx = -INFINITY;
#ifndef DSA_NOSM
#pragma unroll
        for (int g = 0; g < 16; ++g) { const v2u i4 = *(const LAS v2u*)(list + 16 * g + 4 * fq);
#pragma unroll
            for (int i = 0; i < 4; ++i) { const unsigned id = (i & 1) ? (i4[i >> 1] >> 16) : (i4[i >> 1] & 0xffffu); const bool ok = id != 0xFFFFu;
                const int rel = ok ? tok - (int)id : 0; const int bk = BUCK[rel];
                const float lg = ok ? sr[g][i] * 0.08838834764831845f + BIAS[bk * 16 + fr] : -INFINITY; sr[g][i] = lg; mx = fmaxf(mx, lg); }
            if (g & 1) __builtin_amdgcn_sched_barrier(0); }
#endif
        mx = fmaxf(mx, __shfl_xor(mx, 16)); mx = fmaxf(mx, __shfl_xor(mx, 32));
        float sum = 0.f;
#pragma unroll
        for (int g = 0; g < 16; ++g)
#pragma unroll
            for (int i = 0; i < 4; ++i) { const float e = __expf(sr[g][i] - mx); sr[g][i] = e; sum += e; }
        sum += __shfl_xor(sum, 16); sum += __shfl_xor(sum, 32);
        const float inv = 1.0f / sum;
        v4u pbs[8];
#pragma unroll
        for (int c8 = 0; c8 < 8; ++c8) { pbs[c8].x = pk2(sr[2 * c8][0], sr[2 * c8][1]); pbs[c8].y = pk2(sr[2 * c8][2], sr[2 * c8][3]); pbs[c8].z = pk2(sr[2 * c8 + 1][0], sr[2 * c8 + 1][1]); pbs[c8].w = pk2(sr[2 * c8 + 1][2], sr[2 * c8 + 1][3]); asm volatile("" : "+v"(pbs[c8])); }
        f32x4 O[8];
#pragma unroll
        for (int c = 0; c < 8; ++c) O[c] = (f32x4){0.f, 0.f, 0.f, 0.f};
#ifndef DSA_NOPV
        LAS unsigned char* VTw = VT + fq * VT_P + fr * 16;
        LAS unsigned char* VTr = VT + (8 * fq + ((lane_a & 15) >> 2)) * VT_P + 8 * (lane_a & 3);
        v4u vreg[8];
#pragma unroll
        for (int i = 0; i < 8; ++i) { const int rho = 4 * i + fq;
            const unsigned id = list[16 * ((rho >> 2) & 1) + 4 * (rho >> 3) + (rho & 3)]; const unsigned key = id == 0xFFFFu ? 0u : id;
            vreg[i] = *(const v4u*)(kv + (rowb + key) * 256 + 128 + 8 * fr); }
#pragma unroll
        for (int c8 = 0; c8 < 8; ++c8) {
            asm volatile("" ::: "memory");
#pragma unroll
            for (int i = 0; i < 8; ++i) { asm volatile("" : "+v"(vreg[i])); *(LAS v4u*)(VTw + i * (4 * VT_P)) = vreg[i]; }
            asm volatile("s_waitcnt lgkmcnt(0)" ::: "memory");
            if (c8 < 7) {
#pragma unroll
                for (int i = 0; i < 8; ++i) { const int rho = 4 * i + fq;
                    const unsigned id = list[16 * (2 * (c8 + 1) + ((rho >> 2) & 1)) + 4 * (rho >> 3) + (rho & 3)]; const unsigned key = id == 0xFFFFu ? 0u : id;
                    vreg[i] = *(const v4u*)(kv + (rowb + key) * 256 + 128 + 8 * fr); }
            }
            const bf16x8 pb = __builtin_bit_cast(bf16x8, pbs[c8]);
#pragma unroll
            for (int c = 0; c < 8; ++c) {
                const v4i16_t x0 = __builtin_amdgcn_ds_read_tr16_b64_v4i16((LAS v4i16_t*)(VTr + 32 * c)), x1 = __builtin_amdgcn_ds_read_tr16_b64_v4i16((LAS v4i16_t*)(VTr + 4 * VT_P + 32 * c));
                bf16x8 va; va[0] = x0[0]; va[1] = x0[1]; va[2] = x0[2]; va[3] = x0[3]; va[4] = x1[0]; va[5] = x1[1]; va[6] = x1[2]; va[7] = x1[3];
                O[c] = __builtin_amdgcn_mfma_f32_16x16x32_bf16(va, pb, O[c], 0, 0, 0); if (c == 3) __builtin_amdgcn_sched_barrier(0); }
            asm volatile("s_waitcnt lgkmcnt(0)" ::: "memory");
        }
#endif
        bf16* op = proj + (rowb + tok) * NP + C_Q + fr * 128 + 4 * fq;
#pragma unroll
        for (int c = 0; c < 8; ++c) { v2u w; w.x = pk2(O[c][0] * inv, O[c][1] * inv); w.y = pk2(O[c][2] * inv, O[c][3] * inv); if (STORE || w.x == 0x12345678u) *(v2u*)(op + 16 * c) = w; }
    }
    }
}
#ifndef PHM
#define PHM 0xFFFF
#endif
#ifndef ALIGN_P5
#define ALIGN_P5 true
#endif
#ifndef DUP_P5
#define DUP_P5 0
#endif
#ifndef DUP_P0
#define DUP_P0 0
#endif
#ifndef DUP_P15
#define DUP_P15 0
#endif
#ifndef DUP_DSA_ATT
#define DUP_DSA_ATT true
#endif
#ifndef DUP_P1
#define DUP_P1 0
#endif
#ifndef DUP_LRU
#define DUP_LRU 0
#endif
#ifndef DUP_DSA
#define DUP_DSA 0
#endif
#define GBAR() do { TIDS(); XcdBarrier b2_ = bar; asm volatile("" : "+s"(b2_.x)); xcd_barrier(b2_, tid); } while (0)
#define GEMM_PHASE_A(EpiT, g, E, AL) do { pg8::StaticOrder S_; S_.init((g).M, (g).N, G, (int)blockIdx.x); TIDS(); pg8::gemm_phase<EpiT, pg8::StaticOrder, AL, true>(lds, g, S_, E, tid); } while (0)
#define GEMM_PHASE(EpiT, g, E) GEMM_PHASE_A(EpiT, g, E, true)
__global__ void __launch_bounds__(512, 2) fwd_kernel(P p) {
    extern __shared__ __attribute__((aligned(16))) unsigned char lds_raw[];
    LAS unsigned char* lds = (LAS unsigned char*)lds_raw;
    cg::grid_group grid = cg::this_grid();
    const int G = gridDim.x, NGW = G * 8;
    const int wave_s = __builtin_amdgcn_readfirstlane((int)(threadIdx.x >> 6));
    if (threadIdx.x < 2) ((LAS unsigned*)(lds + LDS_BYTES - 256))[threadIdx.x] = 0u;
    XcdBarrier bar = xcd_barrier_post((unsigned*)(p.ws + WS_CTL), (volatile LAS unsigned*)(lds + LDS_BYTES - 256), (int)threadIdx.x);
#define TIDS() unsigned om_ = 0xFFFFFFFFu; asm volatile("" : "+s"(om_)); int tid = wave_s * 64 + (int)__builtin_amdgcn_mbcnt_hi(om_, __builtin_amdgcn_mbcnt_lo(om_, 0u)); const int lane = tid & 63, wave = wave_s, gw = blockIdx.x * 8 + wave; (void)gw; (void)lane
    bf16* proj = (bf16*)(p.ws + WS_PROJ);
#if PHM & 1
    { TIDS(); phase0(p, lds, gw, NGW, lane, wave); }
#if DUP_P0
    { TIDS(); phase0(p, lds, gw, NGW, lane, wave); }
#endif
#endif
    grid.sync();
#if PHM & 2
    { pg8::Gemm g{(const bf16*)(p.ws + WS_XB), (const bf16*)(p.ws + WS_WINT), T_, NP, D_, D_, 0}; pg8::EpiBf16<0> E{proj, NP, nullptr, 0, 0, 1.f}; GEMM_PHASE(pg8::EpiBf16<0>, g, E); }
#endif
    GBAR();
#if DUP_P1
    { pg8::Gemm g{(const bf16*)(p.ws + WS_XB), (const bf16*)(p.ws + WS_WINT), T_, NP, D_, D_, 0}; pg8::EpiBf16<0> E{proj, NP, nullptr, 0, 0, 1.f}; GEMM_PHASE(pg8::EpiBf16<0>, g, E); }
    GBAR();
#endif
#if PHM & 4
    { TIDS(); phase15(p, lds, gw, NGW, lane, wave); }
#if DUP_P15
    { TIDS(); phase15(p, lds, gw, NGW, lane, wave); }
#endif
#endif
    GBAR();
#if DUP_LRU
    { TIDS(); for (int u = blockIdx.x; u < 256; u += G) lru_unit<false>(p, lds, u, tid, lane, wave); }
#endif
#if DUP_DSA
    { TIDS(); dsa_tables(p, lds, tid);
    for (int w = blockIdx.x; w < 256; w += G) { const int b = w >> 5, j = w & 31;
#pragma unroll 1
        for (int q = 0; q < 4; ++q) { const int tg = q == 0 ? j : q == 1 ? 63 - j : q == 2 ? 64 + j : 127 - j; dsa_unit<false, DUP_DSA_ATT>(p, lds, b, tg, lane, wave); } } __syncthreads(); }
#endif
#if PHM & 8
    { TIDS(); for (int u = blockIdx.x; u < 256; u += G) lru_unit<true>(p, lds, u, tid, lane, wave); }
#endif
#if PHM & 16
    { TIDS(); dsa_tables(p, lds, tid);
    for (int w = blockIdx.x; w < 256; w += G) { const int b = w >> 5, j = w & 31;
#pragma unroll 1
        for (int q = 0; q < 4; ++q) { const int tg = q == 0 ? j : q == 1 ? 63 - j : q == 2 ? 64 + j : 127 - j; dsa_unit<true>(p, lds, b, tg, lane, wave); } } }
#endif
    GBAR();
#if PHM & 32
    { pg8::Gemm g{proj + C_LG, (const bf16*)(p.ws + WS_WLA), T_, 2 * D_, D_, NP, (size_t)D_ * 2}; pg8::EpiMerge E{proj, NP, C_GL, C_GA, p.out, D_, proj, NP};
      pg8::PairOrder S_; S_.init(T_, D_, G, (int)blockIdx.x); TIDS(); pg8::gemm_phase<pg8::EpiMerge, pg8::PairOrder, true, true>(lds, g, S_, E, tid); }
#endif
    GBAR();
#if PHM & 64
    { pg8::Gemm g{proj, (const bf16*)(p.ws + WS_WOUT), T_, D_, D_, NP, 0}; pg8::EpiResid E{p.x, p.out, D_, ALPHA}; GEMM_PHASE(pg8::EpiResid, g, E); }
#endif
    GBAR();
    { TIDS(); ln_rows(p.out, (bf16*)(p.ws + WS_H1B), p.ln1_g, p.ln1_b, gw, NGW, lane); }
    GBAR();
#if PHM & 128
    { pg8::Gemm g{(const bf16*)(p.ws + WS_H1B), (const bf16*)(p.ws + WS_WUP), T_, FF2, D_, D_, 0}; pg8::EpiGeglu E{(bf16*)(p.ws + WS_ACT), FF, p.fc_w, p.fc_b, (float*)(p.ws + WS_HEAD), (float*)(p.ws + WS_TAIL), FF}; GEMM_PHASE_A(pg8::EpiGeglu, g, E, ALIGN_P5); }
#if DUP_P5
    GBAR();
    { pg8::Gemm g{(const bf16*)(p.ws + WS_H1B), (const bf16*)(p.ws + WS_WUP), T_, FF2, D_, D_, 0}; pg8::EpiGeglu E{(bf16*)(p.ws + WS_ACT), FF, p.fc_w, p.fc_b, (float*)(p.ws + WS_HEAD), (float*)(p.ws + WS_TAIL), FF}; GEMM_PHASE_A(pg8::EpiGeglu, g, E, ALIGN_P5); }
#endif
#endif
    GBAR();
    { TIDS(); ffn_fixup(p, blockIdx.x * 512 + tid, G * 512); }
    GBAR();
#if PHM & 256
    { pg8::Gemm g{(const bf16*)(p.ws + WS_ACT), (const bf16*)(p.ws + WS_WDN), T_, D_, FF, FF, 0}; pg8::EpiResid E{p.out, p.out, D_, ALPHA}; GEMM_PHASE(pg8::EpiResid, g, E); }
#endif
    GBAR();
    { TIDS(); ln_rows(p.out, nullptr, p.ln2_g, p.ln2_b, gw, NGW, lane); }
}

extern "C" void kernel_launch(void* const* d_in, const int* in_sizes, int n_in, void* d_out, int out_size, void* d_ws, size_t ws_size, hipStream_t stream) {
    static int grid = 0;
    if (grid == 0) {
        if (n_in != 23 || out_size != T_ * D_ || ws_size < WS_END) { fprintf(stderr, "kernel_launch: unexpected shapes (n_in %d out %d ws %zu)\n", n_in, out_size, ws_size); grid = -1; return; }
        int dev = 0, cus = 0, per_cu = 0;
        (void)hipGetDevice(&dev); (void)hipDeviceGetAttribute(&cus, hipDeviceAttributeMultiprocessorCount, dev);
        (void)hipFuncSetAttribute((const void*)fwd_kernel, hipFuncAttributeMaxDynamicSharedMemorySize, LDS_BYTES);
        if (hipOccupancyMaxActiveBlocksPerMultiprocessor(&per_cu, (const void*)fwd_kernel, 512, LDS_BYTES) != hipSuccess || per_cu < 1) per_cu = 1;
        (void)hipGetLastError();
        grid = cus * per_cu;
    }
    if (grid < 0) return;
    (void)hipMemsetAsync((char*)d_ws + WS_CTL, 0, 16384, stream);
    P p{};
    const float** pp = (const float**)&p;
    for (int i = 0; i < 23; ++i) pp[i] = (const float*)d_in[i];
    p.out = (float*)d_out; p.ws = (unsigned char*)d_ws;
    void* args[] = {&p};
    hipError_t e = hipLaunchCooperativeKernel((const void*)fwd_kernel, dim3(grid), dim3(512), args, LDS_BYTES, stream);
    if (e != hipSuccess) fprintf(stderr, "cooperative launch failed: %s (grid %d)\n", hipGetErrorString(e), grid);
}
```
